# Optimizing an MI355X kernel written in HIP

```python
import jax, jax.numpy as jnp
from jax import lax
import numpy as np

D_MODEL = 2048
BATCH = 16
SEQ = 2048
DEPTH = 1

D_MIX = D_MODEL
HEAD_CH = 64
D_A = D_MIX // 2
D_B = D_MIX - D_A
D_IN_PROJ = 3 * D_A + 2 * D_B
K_SHORT = 3
K_CONF = 31
N_EXPERTS = 64
TOP_K = 8
N_EXPERT_GROUPS = 8
TOPK_GROUPS = 4
D_EXPERT = D_MODEL // 4
D_SHARED = D_EXPERT
ROUTED_SCALE = 2.5
DISPATCH_BLOCK = 256
EPS = 1e-6

kernel_name = "hybrid_shortconv_conformer_moe_adaln"


def _rmsnorm(x, g):
    xf = x.astype(jnp.float32)
    y = xf * lax.rsqrt(jnp.mean(xf * xf, axis=-1, keepdims=True) + EPS)
    return (y * g.astype(jnp.float32)).astype(x.dtype)


def _head_rmsnorm(y, g):
    shp = y.shape
    yf = y.astype(jnp.float32).reshape(shp[:-1] + (shp[-1] // HEAD_CH, HEAD_CH))
    yf = yf * lax.rsqrt(jnp.mean(yf * yf, axis=-1, keepdims=True) + EPS)
    return (yf.reshape(shp) * g.astype(jnp.float32)).astype(y.dtype)


def _layernorm(x, g, b):
    xf = x.astype(jnp.float32)
    mu = jnp.mean(xf, axis=-1, keepdims=True)
    var = jnp.mean(jnp.square(xf - mu), axis=-1, keepdims=True)
    y = (xf - mu) * lax.rsqrt(var + EPS)
    return (y * g.astype(jnp.float32) + b.astype(jnp.float32)).astype(x.dtype)


def _causal_depthwise_conv(u, w):
    k, ch = w.shape
    return lax.conv_general_dilated(
        u, w[:, None, :].astype(u.dtype), window_strides=(1,), padding=[(k - 1, 0)],
        dimension_numbers=("NWC", "WIO", "NWC"), feature_group_count=ch)


def _modulate(h, shift, scale):
    return h * (1.0 + scale[:, None, :]) + shift[:, None, :]


def _mixer(h, w_in, conv_a_w, conv_b_w, conv_b_b, ln_b_g, ln_b_b, head_norm_a_g, head_norm_b_g, w_out):
    proj = jnp.einsum("bsd,de->bse", h, w_in)
    xa, ba, ca, vb, gb = jnp.split(proj, [D_A, 2 * D_A, 3 * D_A, 3 * D_A + D_B], axis=-1)
    ya = ba * _causal_depthwise_conv(ca * xa, conv_a_w)
    glu = vb * jax.nn.sigmoid(gb)
    zb = _causal_depthwise_conv(glu, conv_b_w) + conv_b_b
    zb = jax.nn.silu(_layernorm(zb, ln_b_g, ln_b_b))
    y = jnp.concatenate([_head_rmsnorm(ya, head_norm_a_g), _head_rmsnorm(zb, head_norm_b_g)], axis=-1)
    return jnp.einsum("bse,ed->bsd", y, w_out)


def _swiglu(x, wg, wu, wd):
    return (jax.nn.silu(x @ wg) * (x @ wu)) @ wd


def _moe(h, w_router, router_bias, w_gate, w_up, w_down, ws_gate, ws_up, ws_down):
    bsz, seq, d = h.shape
    n_tok = bsz * seq
    hf = h.reshape(n_tok, d)
    scores = jax.nn.sigmoid(hf.astype(jnp.float32) @ w_router.astype(jnp.float32))
    biased = scores + router_bias.astype(jnp.float32)
    grp = biased.reshape(n_tok, N_EXPERT_GROUPS, N_EXPERTS // N_EXPERT_GROUPS)
    grp_score = lax.top_k(grp, 2)[0].sum(-1)
    _, top_grp = lax.top_k(grp_score, TOPK_GROUPS)
    grp_mask = jnp.any(top_grp[:, :, None] == jnp.arange(N_EXPERT_GROUPS)[None, None, :], axis=1)
    exp_mask = jnp.repeat(grp_mask, N_EXPERTS // N_EXPERT_GROUPS, axis=1)
    _, idx = lax.top_k(jnp.where(exp_mask, biased, -jnp.inf), TOP_K)
    wts = jnp.take_along_axis(scores, idx, axis=1)
    wts = (wts / jnp.sum(wts, axis=-1, keepdims=True) * ROUTED_SCALE).astype(h.dtype)

    n_assign = n_tok * TOP_K
    n_blocks = (n_assign + N_EXPERTS * (DISPATCH_BLOCK - 1) + DISPATCH_BLOCK - 1) // DISPATCH_BLOCK
    flat_e = idx.reshape(-1)
    flat_tok = jnp.arange(n_assign, dtype=jnp.int32) // TOP_K
    flat_w = wts.reshape(-1)
    order = jnp.argsort(flat_e)
    e_sorted = flat_e[order]
    counts = jnp.bincount(flat_e, length=N_EXPERTS)
    start = jnp.cumsum(counts) - counts
    padded = (counts + DISPATCH_BLOCK - 1) // DISPATCH_BLOCK * DISPATCH_BLOCK
    pend = jnp.cumsum(padded)
    pstart = pend - padded
    dest = pstart[e_sorted] + jnp.arange(n_assign) - start[e_sorted]
    n_rows = n_blocks * DISPATCH_BLOCK
    buf_tok = jnp.zeros((n_rows,), jnp.int32).at[dest].set(flat_tok[order])
    buf_w = jnp.zeros((n_rows,), h.dtype).at[dest].set(flat_w[order])
    block_e = jnp.minimum(
        jnp.searchsorted(pend, jnp.arange(n_blocks) * DISPATCH_BLOCK, side="right"), N_EXPERTS - 1)

    def body(acc, blk):
        tok, wt, e = blk
        yb = _swiglu(hf[tok], w_gate[e], w_up[e], w_down[e])
        return acc.at[tok].add(yb * wt[:, None]), None

    routed, _ = lax.scan(body, jnp.zeros_like(hf),
                         (buf_tok.reshape(n_blocks, DISPATCH_BLOCK),
                          buf_w.reshape(n_blocks, DISPATCH_BLOCK), block_e))
    shared = _swiglu(hf, ws_gate, ws_up, ws_down)
    return (routed + shared).reshape(bsz, seq, d)


def setup_inputs(seed: int = 0) -> dict:
    key = jax.random.key(seed)
    ks = jax.random.split(key, 24)
    L, D, E, F = DEPTH, D_MODEL, N_EXPERTS, D_EXPERT
    nrm = lambda k, shp, s: jax.random.normal(k, shp, jnp.float32) * s
    gain = lambda k, shp: 1.0 + 0.02 * jax.random.normal(k, shp, jnp.float32)
    return {
        "x": nrm(ks[0], (BATCH, SEQ, D), 1.0),
        "c": nrm(ks[1], (BATCH, D), 1.0),
        "w_ada": nrm(ks[2], (L, D, 6 * D), 0.5 * D ** -0.5),
        "b_ada": nrm(ks[3], (L, 6 * D), 0.02),
        "norm_mix_g": gain(ks[4], (L, D)),
        "w_in": nrm(ks[5], (L, D, D_IN_PROJ), D ** -0.5),
        "conv_a_w": nrm(ks[6], (L, K_SHORT, D_A), K_SHORT ** -0.5),
        "conv_b_w": nrm(ks[7], (L, K_CONF, D_B), K_CONF ** -0.5),
        "conv_b_b": nrm(ks[8], (L, D_B), 0.02),
        "ln_b_g": gain(ks[9], (L, D_B)),
        "ln_b_b": nrm(ks[10], (L, D_B), 0.02),
        "head_norm_a_g": gain(ks[11], (L, D_A)),
        "head_norm_b_g": gain(ks[12], (L, D_B)),
        "w_out": nrm(ks[13], (L, D_MIX, D), D_MIX ** -0.5),
        "norm_ffn_g": gain(ks[14], (L, D)),
        "w_router": nrm(ks[15], (L, D, E), D ** -0.5),
        "router_bias": nrm(ks[16], (L, E), 0.01),
        "w_gate": nrm(ks[17], (L, E, D, F), D ** -0.5),
        "w_up": nrm(ks[18], (L, E, D, F), D ** -0.5),
        "w_down": nrm(ks[19], (L, E, F, D), F ** -0.5),
        "w_shared_gate": nrm(ks[20], (L, D, D_SHARED), D ** -0.5),
        "w_shared_up": nrm(ks[21], (L, D, D_SHARED), D ** -0.5),
        "w_shared_down": nrm(ks[22], (L, D_SHARED, D), D_SHARED ** -0.5),
        "norm_final_g": gain(ks[23], (D,)),
    }


def reference(x, c, w_ada, b_ada, norm_mix_g, w_in, conv_a_w, conv_b_w, conv_b_b, ln_b_g, ln_b_b,
              head_norm_a_g, head_norm_b_g, w_out, norm_ffn_g, w_router, router_bias, w_gate, w_up,
              w_down, w_shared_gate, w_shared_up, w_shared_down, norm_final_g):
    c_act = jax.nn.silu(c)
    for l in range(DEPTH):
        mod = c_act @ w_ada[l] + b_ada[l]
        sh_m, sc_m, g_m, sh_f, sc_f, g_f = jnp.split(mod, 6, axis=-1)
        h = _modulate(_rmsnorm(x, norm_mix_g[l]), sh_m, sc_m)
        x = x + g_m[:, None, :] * _mixer(h, w_in[l], conv_a_w[l], conv_b_w[l], conv_b_b[l], ln_b_g[l],
                                         ln_b_b[l], head_norm_a_g[l], head_norm_b_g[l], w_out[l])
        h = _modulate(_rmsnorm(x, norm_ffn_g[l]), sh_f, sc_f)
        x = x + g_f[:, None, :] * _moe(h, w_router[l], router_bias[l], w_gate[l], w_up[l], w_down[l],
                                       w_shared_gate[l], w_shared_up[l], w_shared_down[l])
    return _rmsnorm(x, norm_final_g)
```

```cpp
#include <hip/hip_runtime.h>
#include <cstdio>
#include <cstdint>

#ifndef MK_N_LAUNCHES
#define MK_N_LAUNCHES 1
#endif
#ifndef REPEAT_MASK
#define REPEAT_MASK 0
#endif

#define GAS __attribute__((address_space(1)))
#define LAS __attribute__((address_space(3)))
typedef unsigned short bf16_t;
typedef short bf16x8 __attribute__((ext_vector_type(8)));
typedef float f32x4 __attribute__((ext_vector_type(4)));
typedef float f32x2 __attribute__((ext_vector_type(2)));
typedef unsigned u32x4 __attribute__((ext_vector_type(4)));
typedef unsigned u32x2 __attribute__((ext_vector_type(2)));

constexpr int T = 32768, D = 2048, NB_ = 16, SEQ = 2048, NE = 64, FE = 512, NPROJ = 5120, TOPK = 8;
constexpr int DA = 1024;
constexpr float EPS = 1e-6f;
constexpr int NWAVES = 8, NTHR = 512;
constexpr int MAXBLK = 1215;

constexpr size_t MiB = 1u << 20;
constexpr size_t WS_CTL = 0, CTL_ZERO_BYTES = 1 * MiB;
constexpr size_t WS_MOD = 1 * MiB;
constexpr size_t WS_SSQ = 2 * MiB;
constexpr size_t WS_TOKE = 6 * MiB;
constexpr size_t WS_TOKR = 7 * MiB;
constexpr size_t WS_TOKW = 8 * MiB;
constexpr size_t WS_INVT = 9 * MiB;
constexpr size_t WS_WRT = 18 * MiB;
constexpr size_t WS_W2T = 32 * MiB;
constexpr size_t WS_ACT = 162 * MiB;
constexpr size_t WS_X2 = 320 * MiB;
constexpr size_t WS_UBG = 162 * MiB;
constexpr size_t WS_Y = 466 * MiB;
constexpr size_t WS_W1T = 466 * MiB;
constexpr size_t WS_WINT = 726 * MiB;
constexpr size_t WS_WOUTT = 746 * MiB;
constexpr size_t WS_H2 = 754 * MiB;
constexpr size_t WS_H = 882 * MiB;
constexpr size_t WS_END = 1074 * MiB;
static_assert(WS_Y + (size_t)MAXBLK * 256 * 2048 <= WS_END, "ws map");
static_assert(WS_ACT + (size_t)MAXBLK * 256 * 512 * 2 <= WS_Y, "ws map");
constexpr int CW_BAR = 4096;
constexpr int CW_GCOUNT = 8192;

constexpr int RING_BYTES = 131072;
constexpr int TBL_OFF = RING_BYTES;
constexpr int TBL_BLKE = TBL_OFF, TBL_BSTART = TBL_OFF + 1280, TBL_CNT = TBL_BSTART + 66 * 4 + 8;
constexpr int MISC_OFF = RING_BYTES + 4096;
constexpr int GATH_OFF = RING_BYTES + 4096 + 256;
constexpr int LDS_BYTES = 147456;
static_assert(GATH_OFF + 8192 <= LDS_BYTES, "LDS map");
static_assert(TBL_CNT + 64 * 4 <= MISC_OFF && MISC_OFF + 128 <= LDS_BYTES, "LDS map");

__device__ __forceinline__ unsigned f2bf(float f) { unsigned u = __builtin_bit_cast(unsigned, f); return (u + 0x7fffu + ((u >> 16) & 1u)) >> 16; }
__device__ __forceinline__ float bflo(unsigned w) { return __uint_as_float(w << 16); }
__device__ __forceinline__ float bfhi(unsigned w) { return __uint_as_float(w & 0xffff0000u); }
template <int CTRL> __device__ __forceinline__ float dpp_mov(float v) { return __builtin_bit_cast(float, __builtin_amdgcn_update_dpp(0, __builtin_bit_cast(int, v), CTRL, 0xF, 0xF, true)); }
__device__ __forceinline__ float row_sum16(float v) {
    v += dpp_mov<0xB1>(v); v += dpp_mov<0x4E>(v); v += dpp_mov<0x141>(v); v += dpp_mov<0x140>(v); return v; }
__device__ __forceinline__ float rdlane(float v, int l) { return __builtin_bit_cast(float, __builtin_amdgcn_readlane(__builtin_bit_cast(int, v), l)); }
__device__ __forceinline__ float wave_sum(float v) { v = row_sum16(v); return (rdlane(v, 0) + rdlane(v, 16)) + (rdlane(v, 32) + rdlane(v, 48)); }
__device__ __forceinline__ float fast_sigmoid(float x) { return __builtin_amdgcn_rcpf(1.0f + __builtin_amdgcn_exp2f(-1.44269504089f * x)); }
constexpr float SC_H = 16.0f, SC_WI = 512.0f;
constexpr float SC_H2 = 16.0f, SC_W1 = 512.0f, SC_ACT = 8.0f, SC_W2 = 4.0f, SC_Y = SC_ACT * SC_W2;
__device__ __forceinline__ float clamp448(float v) { return __builtin_amdgcn_fmed3f(v, -448.0f, 448.0f); }
__device__ __forceinline__ unsigned pk4_fp8(float a, float b, float c, float d) {
    int r = __builtin_amdgcn_cvt_pk_fp8_f32(clamp448(a), clamp448(b), 0, false);
    r = __builtin_amdgcn_cvt_pk_fp8_f32(clamp448(c), clamp448(d), r, true);
    return (unsigned)r;
}
typedef int i32x8 __attribute__((ext_vector_type(8)));
typedef int i32x4v __attribute__((ext_vector_type(4)));
__device__ __forceinline__ unsigned cvt_pk_bf16(float lo, float hi) { unsigned r; asm volatile("v_cvt_pk_bf16_f32 %0, %1, %2" : "=v"(r) : "v"(lo), "v"(hi)); return r; }
__device__ __forceinline__ unsigned pk2(float lo, float hi) { unsigned r; asm("v_cvt_pk_bf16_f32 %0, %1, %2" : "=v"(r) : "v"(lo), "v"(hi)); return r; }
__device__ __forceinline__ float rsq(float x) { return __builtin_amdgcn_rsqf(x); }

#define XB_TMO      128
#define XB_XCNT(j)  (256  + 64 * (j))
#define XB_XSUB(j)  (1280 + 64 * (j))
#define XB_XGEN(j)  (2304 + 64 * (j))
#define XB_TOP      3328
#define XB_TOPGEN   3392
#define XCD_BAR_WORDS 3456
#define XB_SPIN_CAP (1u << 18)
__device__ __forceinline__ unsigned xb_ld(unsigned* p)              { return __hip_atomic_load(p, __ATOMIC_RELAXED, __HIP_MEMORY_SCOPE_AGENT); }
__device__ __forceinline__ unsigned xb_add(unsigned* p, unsigned v) { return __hip_atomic_fetch_add(p, v, __ATOMIC_RELAXED, __HIP_MEMORY_SCOPE_AGENT); }
__device__ __forceinline__ unsigned xb_xcc_id() { return (unsigned)__builtin_amdgcn_s_getreg((3 << 11) | 20) & 0xFu; }
#define XB_SPIN(cond, bar) do { unsigned _sp = 0; while (cond) { __builtin_amdgcn_s_sleep(1); \
    if ((++_sp & 255u) == 0u) { if (xb_ld(&(bar)[XB_TMO])) break; if (_sp > XB_SPIN_CAP) { atomicAdd(&(bar)[XB_TMO], 1u); break; } } } } while (0)
struct XcdBarrier { unsigned* bar; unsigned x; volatile LAS unsigned* st; };
__device__ __forceinline__ XcdBarrier xcd_barrier_post(unsigned* bar, volatile LAS unsigned* st) {
    XcdBarrier b; b.bar = bar; b.x = xb_xcc_id(); b.st = st;
    if (threadIdx.x == 0) (void)xb_add(&bar[XB_XCNT(b.x)], 1u);
    return b;
}
__device__ __forceinline__ void xcd_barrier_complete(unsigned* bar, unsigned x, unsigned& nloc, unsigned& nx) {
    const unsigned G = gridDim.x * gridDim.y * gridDim.z;
    unsigned sum, cnt, mine, sp = 0u;
    for (;;) {
        sum = 0u; cnt = 0u; mine = 0u;
#pragma unroll
        for (unsigned j = 0; j < 16; ++j) { const unsigned c = xb_ld(&bar[XB_XCNT(j)]); sum += c; cnt += (c > 0u) ? 1u : 0u; mine = (j == x) ? c : mine; }
        if (sum == G) break;
        __builtin_amdgcn_s_sleep(1);
        if ((++sp & 255u) == 0u) { if (xb_ld(&bar[XB_TMO])) break; if (sp > XB_SPIN_CAP) { atomicAdd(&bar[XB_TMO], 1u); break; } }
    }
    nloc = mine > 0u ? mine : 1u; nx = cnt > 0u ? cnt : 1u;
}
__device__ __forceinline__ void xcd_barrier(const XcdBarrier& b) {
    asm volatile("s_waitcnt vmcnt(0)" ::: "memory");
    __syncthreads();
    if (threadIdx.x == 0) {
        unsigned* bar = b.bar;
        __builtin_amdgcn_s_waitcnt(0);
        unsigned nloc = b.st[0], nx = b.st[1];
        if (nloc == 0u) { xcd_barrier_complete(bar, b.x, nloc, nx); b.st[0] = nloc; b.st[1] = nx; }
        const unsigned old = xb_add(&bar[XB_XSUB(b.x)], 1u);
        const unsigned gen = old / nloc;
        if (old + 1u == (gen + 1u) * nloc) {
            __builtin_amdgcn_fence(__ATOMIC_RELEASE, "agent");
            asm volatile("s_waitcnt vmcnt(0)" ::: "memory");
            const unsigned og = xb_add(&bar[XB_TOP], 1u);
            const unsigned tg = og / nx;
            if (og + 1u == (tg + 1u) * nx) xb_add(&bar[XB_TOPGEN], 1u);
            else XB_SPIN(xb_ld(&bar[XB_TOPGEN]) == tg, bar);
            __builtin_amdgcn_fence(__ATOMIC_ACQUIRE, "agent");
            xb_add(&bar[XB_XGEN(b.x)], 1u);
            asm volatile("s_waitcnt vmcnt(0)" ::: "memory");
        } else {
            XB_SPIN(xb_ld(&bar[XB_XGEN(b.x)]) == gen, bar);
            __builtin_amdgcn_fence(__ATOMIC_ACQUIRE, "agent");
            asm volatile("s_waitcnt vmcnt(0)" ::: "memory");
        }
    }
    __syncthreads();
}

namespace pg8 {
constexpr int BM = 256, BK = 64, HALF = 128, HTB = HALF * BK * 2, STAGE_BYTES = 8 * HTB;
__host__ __device__ __forceinline__ int lds_byte(int r, int c) { const int st = (r >> 4) * 2 + (c >> 5), rr = r & 15, cc = c & 31, ob = rr * 64 + cc * 2; return st * 1024 + (ob ^ (((ob >> 9) & 1) << 5)); }
__host__ __device__ __forceinline__ void stage_rc(int b, int& R, int& C) { const int st = b / 1024, sb = b % 1024, swz = sb ^ (((sb >> 9) & 1) << 5); R = (st >> 1) * 16 + swz / 64; C = (st & 1) * 32 + (swz % 64) / 2; }
__host__ __device__ __forceinline__ int perm32(int rho) { const int n = rho >> 4, i = rho & 15; return 8 * (i >> 2) + 4 * n + (i & 3); }

struct Unit { int pm, pn, e; };

struct DenseOrder {
    static constexpr bool GATHER = false;
    int nM, nN, nwg, G, c, KB; const void* Bt;
    __device__ void init(int M, int N, int KB_, int G_, int c_, const void* Bt_) { nM = M / BM; nN = N / BM; nwg = nM * nN; G = G_; c = c_; KB = KB_; Bt = Bt_; }
    __device__ __forceinline__ bool next(int i, Unit& u) const {
        const long L = (long)i * G + c; if (L >= nwg) return false;
        int wgid = (int)L; { const int q = nwg / 8, r = nwg % 8, xcd = wgid % 8, off = wgid / 8; wgid = (xcd < r ? xcd * (q + 1) : r * (q + 1) + (xcd - r) * q) + off; }
        const int nig = 8 * nN, gid = wgid / nig, fm = gid * 8, gsz = (nM - fm) < 8 ? (nM - fm) : 8;
        u.pm = fm + ((wgid % nig) % gsz); u.pn = (wgid % nig) / gsz; u.e = 0; return true;
    }
    __device__ __forceinline__ unsigned b_off(const Unit& u) const { return (unsigned)u.pn * (256u * (unsigned)KB); }
    __device__ __forceinline__ unsigned a_unit_off(const Unit& u) const { return (unsigned)u.pm * (256u * (unsigned)KB); }
    __device__ __forceinline__ void prefetch_rows(const Unit&, LAS unsigned char*, int, int, int) const {}
    __device__ __forceinline__ void fetch_rows(const Unit&, LAS unsigned char*, int, int, int, int, unsigned (&)[2][2]) const {}
};
struct DenseOrderG : DenseOrder {
    static constexpr bool GATHER = true;
    __device__ __forceinline__ unsigned a_unit_off(const Unit&) const { return 0u; }
    __device__ __forceinline__ void fetch_rows(const Unit& u, LAS unsigned char*, int, int, int R0, int C0, unsigned (&v)[2][2]) const {
#pragma unroll
        for (int h = 0; h < 2; ++h)
#pragma unroll
            for (int i = 0; i < 2; ++i) v[h][i] = (unsigned)(u.pm * 256 + 128 * h + R0 + 64 * i) * (unsigned)KB + 2u * C0;
    }
};
template <int MODE, int NPN> struct MoeOrder {
    static constexpr bool GATHER = true;
    const LAS unsigned char* blk_e; const LAS int* blkstart; const LAS int* cnt;
    int NB, G, vcu, KB; const void* Bt; unsigned estride, boff0; const int* inv_tok;
    __device__ __forceinline__ bool next(int i, Unit& u) const {
        const int L = i * G + vcu, grp = L / (8 * NPN), w = L % (8 * NPN), rb = grp * 8 + (w & 7);
        if (rb >= NB) return false;
        u.pm = rb; u.pn = w >> 3; u.e = __builtin_amdgcn_readfirstlane((int)blk_e[rb]); return true;
    }
    __device__ __forceinline__ unsigned b_off(const Unit& u) const { return (unsigned)u.e * estride + boff0 + (unsigned)u.pn * (256u * (unsigned)KB); }
    __device__ __forceinline__ unsigned a_unit_off(const Unit& u) const { return 0u; }
    __device__ __forceinline__ void prefetch_rows(const Unit& u, LAS unsigned char* slots, int wid, int lane, int R0) const {
        if (MODE == 0) {
            const int lb = u.pm - __builtin_amdgcn_readfirstlane(blkstart[u.e]);
            const int n = (u.e < NE) ? __builtin_amdgcn_readfirstlane(cnt[u.e]) : T;
            const int* src = inv_tok + (size_t)u.e * T;
#pragma unroll
            for (int h = 0; h < 2; ++h)
#pragma unroll
                for (int i = 0; i < 2; ++i) { int rank = lb * 256 + 128 * h + R0 + 64 * i; rank = rank < n ? rank : n - 1;
                    __builtin_amdgcn_global_load_lds((const unsigned*)(src + rank), (LAS unsigned*)(slots + wid * 1024 + (h * 2 + i) * 256), 4, 0, 0); }
        }
    }
    __device__ __forceinline__ void fetch_rows(const Unit& u, LAS unsigned char* slots, int wid, int lane, int R0, int C0, unsigned (&v)[2][2]) const {
#pragma unroll
        for (int h = 0; h < 2; ++h)
#pragma unroll
            for (int i = 0; i < 2; ++i) {
                int row;
                if (MODE == 0) row = ((const LAS int*)(slots + wid * 1024 + (h * 2 + i) * 256))[lane]; else row = u.pm * 256 + 128 * h + R0 + 64 * i;
                v[h][i] = (unsigned)row * (unsigned)KB + 2u * C0; }
    }
};


struct EpiProj {
    static constexpr int BHALF_ROWS = 128;
    static __device__ __forceinline__ int brow(int R) { return (R & ~31) + perm32(R & 31); }
    bf16_t* U; bf16_t* BA; bf16_t* GLU;
    __device__ __forceinline__ void operator()(const f32x4 (&acc)[2][2][4][2], const Unit& u, int wr, int wc, int fr, int fq) const {
        const int row0 = u.pm * BM + wr * 64 + fr, pn = u.pn;
        if (pn >= 8 && pn < 12) {
            const int col0 = 256 * (pn - 8) + wc * 32 + 8 * fq;
#pragma unroll
            for (int ai = 0; ai < 2; ++ai)
#pragma unroll
                for (int m = 0; m < 4; ++m) { bf16_t* rowp = BA + (size_t)(row0 + ai * HALF + m * 16) * DA + col0;
#pragma unroll
                    for (int bj = 0; bj < 2; ++bj) { constexpr float sp = 1.0f / (SC_H * SC_WI); const f32x4 v0 = acc[ai][bj][m][0] * sp, v1 = acc[ai][bj][m][1] * sp;
                        u32x4 w; w.x = cvt_pk_bf16(v0[0], v0[1]); w.y = cvt_pk_bf16(v0[2], v0[3]); w.z = cvt_pk_bf16(v1[0], v1[1]); w.w = cvt_pk_bf16(v1[2], v1[3]);
                        *(u32x4*)(rowp + bj * HALF) = w; } }
        } else {
            const bool isu = pn < 8; bf16_t* base = isu ? U : GLU; const int col0 = 128 * (isu ? pn : pn - 12) + wc * 32 + 8 * fq;
#pragma unroll
            for (int ai = 0; ai < 2; ++ai)
#pragma unroll
                for (int m = 0; m < 4; ++m) { bf16_t* rowp = base + (size_t)(row0 + ai * HALF + m * 16) * DA + col0;
                    constexpr float sp = 1.0f / (SC_H * SC_WI);
                    f32x4 a0 = acc[ai][0][m][0] * sp, a1 = acc[ai][0][m][1] * sp; const f32x4 b0 = acc[ai][1][m][0] * sp, b1 = acc[ai][1][m][1] * sp;
                    if (isu) { a0 = a0 * b0; a1 = a1 * b1; }
                    else {
#pragma unroll
                        for (int j = 0; j < 4; ++j) { a0[j] = a0[j] * fast_sigmoid(b0[j]); a1[j] = a1[j] * fast_sigmoid(b1[j]); } }
                    u32x4 w; w.x = cvt_pk_bf16(a0[0], a0[1]); w.y = cvt_pk_bf16(a0[2], a0[3]); w.z = cvt_pk_bf16(a1[0], a1[1]); w.w = cvt_pk_bf16(a1[2], a1[3]);
                    *(u32x4*)rowp = w; }
        }
    }
};
struct EpiOut {
    static constexpr int BHALF_ROWS = 128;
    static __device__ __forceinline__ int brow(int R) { return (R & ~31) + perm32(R & 31); }
    const float* x; const float* mod; bf16_t* x2; float* ssq;
    __device__ __forceinline__ void operator()(const f32x4 (&acc)[2][2][4][2], const Unit& u, int wr, int wc, int fr, int fq) const {
        const int row0 = u.pm * BM + wr * 64 + fr, col0 = u.pn * BM + wc * 32 + 8 * fq;
        const float* gm = mod + (size_t)(u.pm >> 3) * (6 * D) + 2 * D;
        f32x4 gv[2][2];
#pragma unroll
        for (int bj = 0; bj < 2; ++bj)
#pragma unroll
            for (int n = 0; n < 2; ++n) gv[bj][n] = *(const f32x4*)(gm + col0 + bj * HALF + 4 * n);
#pragma unroll
        for (int ai = 0; ai < 2; ++ai)
#pragma unroll
          for (int mp = 0; mp < 2; ++mp) {
            f32x4 xv[2][2][2];
#pragma unroll
            for (int mm = 0; mm < 2; ++mm)
#pragma unroll
                for (int bj = 0; bj < 2; ++bj)
#pragma unroll
                    for (int n = 0; n < 2; ++n) xv[mm][bj][n] = *(const f32x4*)(x + (size_t)(row0 + ai * HALF + (2 * mp + mm) * 16) * D + col0 + bj * HALF + 4 * n);
            asm volatile("" ::: "memory");
#pragma unroll
            for (int mm = 0; mm < 2; ++mm) { const int m = 2 * mp + mm; const int row = row0 + ai * HALF + m * 16; const size_t off = (size_t)row * D + col0; float s = 0.f;
#pragma unroll
                for (int bj = 0; bj < 2; ++bj) { const f32x4 o0 = xv[mm][bj][0] + gv[bj][0] * acc[ai][bj][m][0], o1 = xv[mm][bj][1] + gv[bj][1] * acc[ai][bj][m][1];
                    u32x4 w; w.x = pk2(o0[0], o0[1]); w.y = pk2(o0[2], o0[3]); w.z = pk2(o1[0], o1[1]); w.w = pk2(o1[2], o1[3]);
                    *(u32x4*)(x2 + off + bj * HALF) = w;
                    const float r0 = bflo(w.x), r1 = bfhi(w.x), r2 = bflo(w.y), r3 = bfhi(w.y), r4 = bflo(w.z), r5 = bfhi(w.z), r6 = bflo(w.w), r7 = bfhi(w.w);
                    s += ((r0 * r0 + r1 * r1) + (r2 * r2 + r3 * r3)) + ((r4 * r4 + r5 * r5) + (r6 * r6 + r7 * r7)); }
                s += __shfl_xor(s, 16); s += __shfl_xor(s, 32);
                if (fq == 0) ssq[(size_t)(u.pn * 4 + wc) * T + row] = s; }
            asm volatile("" ::: "memory");
          }
    }
};
struct EpiAct {
    static constexpr int BHALF_ROWS = 128;
    static __device__ __forceinline__ int brow(int R) { return (R & ~31) + perm32(R & 31); }
    unsigned char* act;
    __device__ __forceinline__ void operator()(const f32x4 (&acc)[2][2][4][2], const Unit& u, int wr, int wc, int fr, int fq) const {
        const int row0 = u.pm * BM + wr * 64 + fr, col0 = 128 * u.pn + wc * 32 + 8 * fq;
#pragma unroll
        for (int ai = 0; ai < 2; ++ai)
#pragma unroll
            for (int m = 0; m < 4; ++m) { unsigned char* rowp = act + (size_t)(row0 + ai * HALF + m * 16) * FE + col0;
                constexpr float s1 = 1.0f / (SC_H2 * SC_W1), s2 = SC_ACT / (SC_H2 * SC_W1);
                f32x4 a0 = acc[ai][0][m][0] * s1, a1 = acc[ai][0][m][1] * s1; const f32x4 b0 = acc[ai][1][m][0] * s2, b1 = acc[ai][1][m][1] * s2;
#pragma unroll
                for (int j = 0; j < 4; ++j) { a0[j] = a0[j] * fast_sigmoid(a0[j]) * b0[j]; a1[j] = a1[j] * fast_sigmoid(a1[j]) * b1[j]; }
                u32x2 w; w.x = pk4_fp8(a0[0], a0[1], a0[2], a0[3]); w.y = pk4_fp8(a1[0], a1[1], a1[2], a1[3]);
                *(u32x2*)rowp = w; }
    }
};
struct EpiY8 {
    static constexpr int BHALF_ROWS = 8;
    static __device__ __forceinline__ int brow(int R) { return 64 * (R >> 5) + 16 * ((R & 15) >> 2) + 4 * ((R >> 4) & 1) + (R & 3); }
    unsigned char* Y;
    __device__ __forceinline__ void operator()(const f32x4 (&acc)[2][2][4][2], const Unit& u, int wr, int wc, int fr, int fq) const {
        const int row0 = u.pm * BM + wr * 64 + fr, col0 = u.pn * BM + 64 * wc + 16 * fq;
        static_assert(SC_Y == SC_ACT * SC_W2, "y rows are stored unscaled");
#pragma unroll
        for (int ai = 0; ai < 2; ++ai)
#pragma unroll
            for (int m = 0; m < 4; ++m) { unsigned char* rowp = Y + (size_t)(row0 + ai * HALF + m * 16) * D + col0;
                const f32x4 v0 = acc[ai][0][m][0], v1 = acc[ai][0][m][1], v2 = acc[ai][1][m][0], v3 = acc[ai][1][m][1];
                u32x4 w; w.x = pk4_fp8(v0[0], v0[1], v0[2], v0[3]); w.y = pk4_fp8(v1[0], v1[1], v1[2], v1[3]); w.z = pk4_fp8(v2[0], v2[1], v2[2], v2[3]); w.w = pk4_fp8(v3[0], v3[1], v3[2], v3[3]);
                __builtin_nontemporal_store(w, (u32x4*)rowp); }
    }
};

template <bool FP8, class Epi, class Sched>
__device__ __forceinline__ void gemm_phase(LAS unsigned char* lds, const void* A, unsigned abytes, const void* Bt, unsigned bbytes, const int KB_, const Sched& S, const Epi& E) {
    int KB = KB_; asm volatile("" : "+s"(KB));
    const int tid = threadIdx.x, wid = __builtin_amdgcn_readfirstlane(tid >> 6), lane = tid & 63, wr = wid >> 2, wc = wid & 3, fr = lane & 15, fq = lane >> 4;
    const int nt = KB / 128;
    int R0, C0; stage_rc(tid * 16, R0, C0);
    unsigned voffB[2], vd[2];
#pragma unroll
    for (int i = 0; i < 2; ++i) { const int R = R0 + 64 * i; const int Rb = Epi::brow(R); voffB[i] = (unsigned)Rb * (unsigned)KB + 2u * C0; vd[i] = (unsigned)R * (unsigned)KB + 2u * C0; }
    constexpr bool GA = Sched::GATHER;
    LAS unsigned char* slots = lds + GATH_OFF;
    const __amdgpu_buffer_rsrc_t rsA = __builtin_amdgcn_make_buffer_rsrc((void*)A, 0, (int)abytes, 0x00020000);
    const __amdgpu_buffer_rsrc_t rsB = __builtin_amdgcn_make_buffer_rsrc((void*)Bt, 0, (int)bbytes, 0x00020000);
    const unsigned kstep = 128u;
    const unsigned hstep = (unsigned)HALF * (unsigned)KB;
    const unsigned hstepB = (unsigned)Epi::BHALF_ROWS * (unsigned)KB;
    const unsigned ldsw = (unsigned)wid * 1024u;
    const int aoff = lds_byte(wr * 64 + fr, fq * 8), boff = lds_byte(wc * 32 + fr, fq * 8);
#define PG8_SA(b, h) (((b) * 2 + (h)) * HTB)
#define PG8_SB(b, h) ((4 + (b) * 2 + (h)) * HTB)
#define PG8_STAGE(bufoff, rs, soff, voff) do { _Pragma("unroll") for (int _i = 0; _i < 2; ++_i) \
        __builtin_amdgcn_raw_ptr_buffer_load_lds(rs, (LAS void*)(lds + (bufoff) + ldsw + _i * 8192), 16, (int)(voff)[_i], (int)(soff), 0, 0); } while (0)
#define PG8_STAGE_A(bufoff, so, h) do { if constexpr (GA) PG8_STAGE(bufoff, rsA, so, vc[h]); else PG8_STAGE(bufoff, rsA, (so) + (h) * hstep, vd); } while (0)
#define PG8_LDA(dst, b, h) do { _Pragma("unroll") for (int m = 0; m < 4; ++m) { \
        if constexpr (FP8) { const i32x4v _lo = *(const LAS i32x4v*)(lds + PG8_SA(b, h) + aoff + m * 2048), _hi = *(const LAS i32x4v*)(lds + PG8_SA(b, h) + aoff + m * 2048 + 1024); \
            dst##8[m] = __builtin_shufflevector(_lo, _hi, 0, 1, 2, 3, 4, 5, 6, 7); } \
        else { _Pragma("unroll") for (int k = 0; k < 2; ++k) dst[m][k] = *(const LAS bf16x8*)(lds + PG8_SA(b, h) + aoff + m * 2048 + k * 1024); } } } while (0)
#define PG8_LDB(dst, b, h) do { _Pragma("unroll") for (int n = 0; n < 2; ++n) { \
        if constexpr (FP8) { const i32x4v _lo = *(const LAS i32x4v*)(lds + PG8_SB(b, h) + boff + n * 2048), _hi = *(const LAS i32x4v*)(lds + PG8_SB(b, h) + boff + n * 2048 + 1024); \
            dst##8[n] = __builtin_shufflevector(_lo, _hi, 0, 1, 2, 3, 4, 5, 6, 7); } \
        else { _Pragma("unroll") for (int k = 0; k < 2; ++k) dst[n][k] = *(const LAS bf16x8*)(lds + PG8_SB(b, h) + boff + n * 2048 + k * 1024); } } } while (0)
#define PG8_MMA(ai, bj, At, Bt) do { __builtin_amdgcn_s_setprio(1); _Pragma("unroll") for (int m = 0; m < 4; ++m) _Pragma("unroll") for (int n = 0; n < 2; ++n) { \
        if constexpr (FP8) { acc[ai][bj][m][n] = __builtin_amdgcn_mfma_scale_f32_16x16x128_f8f6f4(Bt##8[n], At##8[m], acc[ai][bj][m][n], 0, 0, 0, 0x7F7F7F7F, 0, 0x7F7F7F7F); } \
        else { _Pragma("unroll") for (int k = 0; k < 2; ++k) acc[ai][bj][m][n] = __builtin_amdgcn_mfma_f32_16x16x32_bf16(Bt[n][k], At[m][k], acc[ai][bj][m][n], 0, 0, 0); } } \
        __builtin_amdgcn_s_setprio(0); } while (0)
#define PG8_WAIT_V(n) asm volatile("s_waitcnt vmcnt(" #n ")" ::: "memory")
#define PG8_WAIT_L(n) asm volatile("s_waitcnt lgkmcnt(" #n ")" ::: "memory")
#define PG8_BAR __builtin_amdgcn_s_barrier()
#define PG8_SCHED __builtin_amdgcn_sched_barrier(0)
    Unit cur, nxt; int ui = 0;
    if (!S.next(0, cur)) return;
    f32x4 acc[2][2][4][2];
#pragma unroll
    for (int a = 0; a < 2; ++a)
#pragma unroll
        for (int b = 0; b < 2; ++b)
#pragma unroll
            for (int m = 0; m < 4; ++m)
#pragma unroll
                for (int n = 0; n < 2; ++n) acc[a][b][m][n] = (f32x4){0.f, 0.f, 0.f, 0.f};
    bf16x8 At[4][2], B0[2][2], B1[2][2];
    i32x8 At8[4], B08[2], B18[2];
    unsigned cA = S.a_unit_off(cur), cB = S.b_off(cur);
    unsigned vc[2][2] = {{0u, 0u}, {0u, 0u}};
    if constexpr (GA) { S.prefetch_rows(cur, slots, wid, lane, R0); PG8_WAIT_V(0); S.fetch_rows(cur, slots, wid, lane, R0, C0, vc); PG8_WAIT_L(0); }
    PG8_STAGE(PG8_SB(0, 0), rsB, cB, voffB); PG8_STAGE(PG8_SB(0, 1), rsB, cB + hstepB, voffB); PG8_STAGE_A(PG8_SA(0, 0), cA, 0); PG8_STAGE_A(PG8_SA(0, 1), cA, 1);
    if (wr == 1) PG8_BAR;
    PG8_WAIT_V(2); PG8_BAR;
    PG8_STAGE(PG8_SB(1, 0), rsB, cB + kstep, voffB); PG8_STAGE_A(PG8_SA(1, 0), cA + kstep, 0); PG8_STAGE(PG8_SB(1, 1), rsB, cB + hstepB + kstep, voffB);
    PG8_WAIT_V(6); PG8_BAR;
    for (;;) {
        const bool has_next = S.next(ui + 1, nxt);
        unsigned nB = cB, nA = cA;
        if (has_next) { nB = S.b_off(nxt); nA = S.a_unit_off(nxt); if constexpr (GA) S.prefetch_rows(nxt, slots, wid, lane, R0); }
#pragma unroll 1
        for (int t = 0; t < nt; t += 2) {
            const bool last = (t == nt - 2);
            const unsigned a1 = cA + (unsigned)(t + 1) * kstep;
            const unsigned a2 = last ? nA : cA + (unsigned)(t + 2) * kstep, b2 = last ? nB : cB + (unsigned)(t + 2) * kstep;
            const unsigned a3 = a2 + kstep, b3 = b2 + kstep;
            PG8_LDB(B0, 0, 0); PG8_LDB(B1, 0, 1); PG8_SCHED; PG8_LDA(At, 0, 0); PG8_STAGE_A(PG8_SA(1, 1), a1, 1);
            if constexpr (GA) { if (last && has_next) S.fetch_rows(nxt, slots, wid, lane, R0, C0, vc); }
            PG8_WAIT_V(8); PG8_WAIT_L(0); PG8_BAR; PG8_MMA(0, 0, At, B0); PG8_MMA(0, 1, At, B1); PG8_BAR; PG8_SCHED;
            PG8_LDA(At, 0, 1); PG8_STAGE(PG8_SB(0, 0), rsB, b2, voffB); PG8_STAGE(PG8_SB(0, 1), rsB, b2 + hstepB, voffB); PG8_STAGE_A(PG8_SA(0, 0), a2, 0);
            PG8_WAIT_V(8); PG8_WAIT_L(0); PG8_BAR; PG8_MMA(1, 0, At, B0); PG8_MMA(1, 1, At, B1); PG8_BAR; PG8_SCHED;
            PG8_LDB(B0, 1, 0); PG8_LDB(B1, 1, 1); PG8_SCHED; PG8_LDA(At, 1, 0); PG8_STAGE_A(PG8_SA(0, 1), a2, 1);
            PG8_WAIT_V(8); PG8_WAIT_L(0); PG8_BAR; PG8_MMA(0, 0, At, B0); PG8_MMA(0, 1, At, B1); PG8_BAR; PG8_SCHED;
            PG8_LDA(At, 1, 1); PG8_STAGE(PG8_SB(1, 0), rsB, b3, voffB); PG8_STAGE(PG8_SB(1, 1), rsB, b3 + hstepB, voffB); PG8_STAGE_A(PG8_SA(1, 0), a3, 0);
            PG8_WAIT_V(8); PG8_WAIT_L(0); PG8_BAR; PG8_MMA(1, 0, At, B0); PG8_MMA(1, 1, At, B1); PG8_BAR; PG8_SCHED;
        }
        if (wr == 0) PG8_BAR;
        E(acc, cur, wr, wc, fr, fq);
        if (!has_next) break;
#pragma unroll
        for (int a = 0; a < 2; ++a)
#pragma unroll
            for (int b = 0; b < 2; ++b)
#pragma unroll
                for (int m = 0; m < 4; ++m)
#pragma unroll
                    for (int n = 0; n < 2; ++n) acc[a][b][m][n] = (f32x4){0.f, 0.f, 0.f, 0.f};
        cur = nxt; cB = nB; cA = nA; ++ui;
        if (wr == 1) PG8_BAR;
    }
    PG8_WAIT_V(0);
    PG8_BAR;
#undef PG8_SA
#undef PG8_SB
#undef PG8_STAGE
#undef PG8_STAGE_A
#undef PG8_LDA
#undef PG8_LDB
#undef PG8_MMA
#undef PG8_WAIT_V
#undef PG8_WAIT_L
#undef PG8_BAR
#undef PG8_SCHED
}
}

struct Args { const float* in[24]; float* out; unsigned char* ws; int ph_lo, ph_hi; };

__device__ __forceinline__ void p0_transpose_item(const float* W, int K, int N, bf16_t* WT, int k0, int n0, int rowbase, LAS float* scr, int lane) {
#pragma unroll 8
    for (int i = 0; i < 32; ++i) { const int kk = 2 * i + (lane >> 5); scr[kk * 33 + (lane & 31)] = W[(size_t)(k0 + kk) * N + n0 + (lane & 31)]; }
    asm volatile("s_waitcnt lgkmcnt(0)" ::: "memory");
    const int c = lane & 7;
#pragma unroll
    for (int j = 0; j < 4; ++j) { const int n = (lane >> 3) + 8 * j; const LAS float* s = scr + (8 * c) * 33 + n;
        u32x4 o; o.x = pk2(s[0 * 33], s[1 * 33]); o.y = pk2(s[2 * 33], s[3 * 33]); o.z = pk2(s[4 * 33], s[5 * 33]); o.w = pk2(s[6 * 33], s[7 * 33]);
        *(u32x4*)(WT + (size_t)(rowbase + n) * K + k0 + 8 * c) = o; }
    asm volatile("s_waitcnt lgkmcnt(0)" ::: "memory");
}
__device__ __forceinline__ void p0_transpose_item_fp8(const float* W, int K, int N, unsigned char* WT, int k0, int n0, int rowbase, float sc, LAS float* scr, int lane) {
#pragma unroll 8
    for (int i = 0; i < 32; ++i) { const int kk = 2 * i + (lane >> 5); scr[kk * 33 + (lane & 31)] = W[(size_t)(k0 + kk) * N + n0 + (lane & 31)]; }
    asm volatile("s_waitcnt lgkmcnt(0)" ::: "memory");
    const int c = lane & 7;
#pragma unroll
    for (int j = 0; j < 4; ++j) { const int n = (lane >> 3) + 8 * j; const LAS float* s = scr + (8 * c) * 33 + n;
        u32x2 o; o.x = pk4_fp8(s[0 * 33] * sc, s[1 * 33] * sc, s[2 * 33] * sc, s[3 * 33] * sc); o.y = pk4_fp8(s[4 * 33] * sc, s[5 * 33] * sc, s[6 * 33] * sc, s[7 * 33] * sc);
        *(u32x2*)(WT + (size_t)(rowbase + n) * K + k0 + 8 * c) = o; }
    asm volatile("s_waitcnt lgkmcnt(0)" ::: "memory");
}
__device__ __forceinline__ void p0_router_item(const float* W, bf16_t* WThi, bf16_t* WTlo, int k0, int n0, LAS float* scr, int lane) {
    constexpr int K = D, N = NE;
#pragma unroll 8
    for (int i = 0; i < 32; ++i) { const int kk = 2 * i + (lane >> 5); scr[kk * 33 + (lane & 31)] = W[(size_t)(k0 + kk) * N + n0 + (lane & 31)]; }
    asm volatile("s_waitcnt lgkmcnt(0)" ::: "memory");
    const int c = lane & 7;
#pragma unroll
    for (int j = 0; j < 4; ++j) { const int n = (lane >> 3) + 8 * j; const LAS float* s = scr + (8 * c) * 33 + n;
        unsigned hi[8], lo[8];
#pragma unroll
        for (int q = 0; q < 8; ++q) { const float v = s[q * 33]; hi[q] = f2bf(v); lo[q] = f2bf(v - __uint_as_float(hi[q] << 16)); }
        u32x4 oh, ol; oh.x = hi[0] | (hi[1] << 16); oh.y = hi[2] | (hi[3] << 16); oh.z = hi[4] | (hi[5] << 16); oh.w = hi[6] | (hi[7] << 16);
        ol.x = lo[0] | (lo[1] << 16); ol.y = lo[2] | (lo[3] << 16); ol.z = lo[4] | (lo[5] << 16); ol.w = lo[6] | (lo[7] << 16);
        *(u32x4*)(WThi + (size_t)(n0 + n) * K + k0 + 8 * c) = oh; *(u32x4*)(WTlo + (size_t)(n0 + n) * K + k0 + 8 * c) = ol; }
    asm volatile("s_waitcnt lgkmcnt(0)" ::: "memory");
}
__device__ __forceinline__ int win_rowbase(int n0) {
    if (n0 < 1024) return 256 * (n0 >> 7) + (n0 & 127);
    if (n0 < 2048) return 2048 + (n0 - 1024);
    if (n0 < 3072) { const int n = n0 - 2048; return 256 * (n >> 7) + 128 + (n & 127); }
    if (n0 < 4096) { const int n = n0 - 3072; return 3072 + 256 * (n >> 7) + (n & 127); }
    { const int n = n0 - 4096; return 3072 + 256 * (n >> 7) + 128 + (n & 127); }
}

__device__ __forceinline__ void build_tables(LAS unsigned char* lds, const unsigned* gcount, int& NBr) {
    LAS unsigned char* blk_e = lds + TBL_BLKE; LAS int* blkstart = (LAS int*)(lds + TBL_BSTART); LAS int* cnt = (LAS int*)(lds + TBL_CNT);
    const int tid = threadIdx.x;
    __syncthreads();
    if (tid < NE) cnt[tid] = (int)gcount[tid];
    __syncthreads();
    if (tid == 0) { int s = 0; for (int e = 0; e < NE; ++e) { blkstart[e] = s; s += (cnt[e] + 255) >> 8; } blkstart[NE] = s; }
    __syncthreads();
    NBr = blkstart[NE];
    if (tid < NE) { const int b0 = blkstart[tid], nb = (cnt[tid] + 255) >> 8; for (int i = 0; i < nb; ++i) blk_e[b0 + i] = (unsigned char)tid; }
    if (tid >= 64 && tid < 64 + 128) blk_e[NBr + tid - 64] = (unsigned char)NE;
    __syncthreads();
}


typedef const __attribute__((address_space(4))) Args* KArgsP;
__device__ __forceinline__ KArgsP kargs() { KArgsP p = (KArgsP)__builtin_amdgcn_kernarg_segment_ptr(); asm volatile("" : "+s"(p)); return p; }
#define WSP(type, name, off) type* name = (type*)(ws + (off))
__global__ void __launch_bounds__(NTHR, 2) fwd_kernel(Args args) {
    extern __shared__ __attribute__((aligned(16))) unsigned char lds_raw[];
    LAS unsigned char* lds = (LAS unsigned char*)lds_raw;
    volatile LAS unsigned* MISC = (volatile LAS unsigned*)(lds + MISC_OFF);
    const int tid = threadIdx.x, lane = tid & 63, wave = __builtin_amdgcn_readfirstlane(tid >> 6);
    const int G = gridDim.x, bx = blockIdx.x;
    const int vcu = (G % 8 == 0) ? (bx % 8) * (G / 8) + bx / 8 : bx;
    unsigned* ctl = (unsigned*)(args.ws + WS_CTL);
    for (int u = tid; u < (LDS_BYTES - MISC_OFF) / 4; u += NTHR) ((LAS unsigned*)(lds + MISC_OFF))[u] = 0u;
    __syncthreads();
    XcdBarrier bar; bar.bar = ctl + CW_BAR; bar.x = 0; bar.st = nullptr;
    if (MK_N_LAUNCHES == 1) bar = xcd_barrier_post(ctl + CW_BAR, MISC + 8);
    const int lo = args.ph_lo, hi = args.ph_hi;
#ifndef PH_MASK
#define PH_MASK 0x1ff
#endif
#define IN(k) ((((PH_MASK) >> (k)) & 1) && lo <= (k) && (k) < hi)
#define SEAM(k) do { if (IN(k) && IN((k) + 1)) xcd_barrier(bar); } while (0)

    if (IN(0)) {
        KArgsP ap = kargs(); unsigned char* ws = ap->ws;
        const float* cvec = ap->in[1]; const float* w_ada = ap->in[2]; const float* b_ada = ap->in[3];
        WSP(float, mod, WS_MOD);
        {
            LAS float* cs = (LAS float*)lds;
            for (int it = bx; it < 192; it += G) {
                __syncthreads();
                for (int i = tid; i < NB_ * D; i += NTHR) { const float v = cvec[i]; cs[i] = v / (1.0f + expf(-v)); }
                __syncthreads();
                const int n0 = 64 * it, cg = tid & 15, rl = tid >> 4;
                float a[16][4];
#pragma unroll
                for (int b = 0; b < 16; ++b) { a[b][0] = 0.f; a[b][1] = 0.f; a[b][2] = 0.f; a[b][3] = 0.f; }
#pragma unroll 2
                for (int kk = rl; kk < D; kk += 32) {
                    const f32x4 w4 = *(const f32x4*)(w_ada + (size_t)kk * (6 * D) + n0 + 4 * cg);
#pragma unroll
                    for (int b = 0; b < 16; ++b) { const float s = cs[b * D + kk]; a[b][0] += s * w4[0]; a[b][1] += s * w4[1]; a[b][2] += s * w4[2]; a[b][3] += s * w4[3]; }
                }
#pragma unroll
                for (int b = 0; b < 16; ++b)
#pragma unroll
                    for (int c = 0; c < 4; ++c) { float v = a[b][c]; v += __shfl_xor(v, 16); v += __shfl_xor(v, 32); a[b][c] = v; }
                __syncthreads();
                LAS float* red = (LAS float*)lds;
                if (lane < 16) {
#pragma unroll
                    for (int b = 0; b < 16; ++b)
#pragma unroll
                        for (int c = 0; c < 4; ++c) red[(wave * 16 + b) * 64 + 4 * cg + c] = a[b][c];
                }
                __syncthreads();
                for (int o = tid; o < 16 * 64; o += NTHR) { const int b = o >> 6, c = o & 63; float s = b_ada[n0 + c];
#pragma unroll
                    for (int w = 0; w < 8; ++w) s += red[(w * 16 + b) * 64 + c];
                    mod[(size_t)b * (6 * D) + n0 + c] = s; }
            }
            __syncthreads();
        }
        {
            const float* w_in = ap->in[5]; const float* w_out = ap->in[13]; const float* w_router = ap->in[15];
            const float* w_gate = ap->in[17]; const float* w_up = ap->in[18]; const float* w_down = ap->in[19];
            const float* ws_gate = ap->in[20]; const float* ws_up = ap->in[21]; const float* ws_down = ap->in[22];
            WSP(bf16_t, WrThi, WS_WRT); bf16_t* WrTlo = WrThi + (size_t)NE * D;
            WSP(unsigned char, W2T, WS_W2T); WSP(unsigned char, W1T, WS_W1T); WSP(bf16_t, WinT, WS_WINT); WSP(bf16_t, WoutT, WS_WOUTT);
            LAS float* scr = (LAS float*)(lds + wave * 16384);
            const int gw = vcu * NWAVES + wave, NGW = G * NWAVES;
            constexpr int I_IN = 32 * 160, I_OUT = 32 * 64, I_GU = 32 * 16, I_DN = 8 * 64, I_RT = 32 * 2;
            constexpr int NITEMS = I_IN + I_OUT + 65 * 2 * I_GU + 65 * I_DN + I_RT;
            for (int it = gw; it < NITEMS; it += NGW) {
                int r = it;
                if (r < I_IN) { const int kb = r / 160, nb = r % 160; p0_transpose_item_fp8(w_in, D, NPROJ, (unsigned char*)WinT, 64 * kb, 32 * nb, win_rowbase(32 * nb), SC_WI, scr, lane); continue; } r -= I_IN;
                if (r < I_OUT) { const int kb = r / 64, nb = r % 64; p0_transpose_item(w_out, D, D, WoutT, 64 * kb, 32 * nb, 32 * nb, scr, lane); continue; } r -= I_OUT;
                if (r < 65 * 2 * I_GU) { const int e = r / (2 * I_GU), r2 = r % (2 * I_GU), isup = r2 / I_GU, r3 = r2 % I_GU, kb = r3 / 16, nb = r3 % 16, n0 = 32 * nb;
                    const float* W = (e < NE) ? ((isup ? w_up : w_gate) + (size_t)e * D * FE) : (isup ? ws_up : ws_gate);
                    p0_transpose_item_fp8(W, D, FE, W1T + (size_t)e * 1024 * D, 64 * kb, n0, 256 * (n0 >> 7) + 128 * isup + (n0 & 127), SC_W1, scr, lane); continue; } r -= 65 * 2 * I_GU;
                if (r < 65 * I_DN) { const int e = r / I_DN, r3 = r % I_DN, kb = r3 / 64, nb = r3 % 64;
                    const float* W = (e < NE) ? (w_down + (size_t)e * FE * D) : ws_down;
                    p0_transpose_item_fp8(W, FE, D, W2T + (size_t)e * D * FE, 64 * kb, 32 * nb, 32 * nb, SC_W2, scr, lane); continue; } r -= 65 * I_DN;
                { const int kb = r / 2, nb = r % 2; p0_router_item(w_router, WrThi, WrTlo, 64 * kb, 32 * nb, scr, lane); }
            }
        }
    }
    SEAM(0);

    if (IN(1)) {
        KArgsP ap = kargs(); unsigned char* ws = ap->ws;
        const float* x = ap->in[0]; const float* norm_mix_g = ap->in[4];
        WSP(float, mod, WS_MOD); WSP(bf16_t, Hb, WS_H);
        LAS float* Av = (LAS float*)lds; LAS float* Bv = Av + D;
        for (int ch = bx; ch < T / 128; ch += G) {
            const int b = ch >> 4; const float* mb = mod + (size_t)b * (6 * D);
            __syncthreads();
            for (int k = tid; k < D; k += NTHR) { Av[k] = norm_mix_g[k] * (1.0f + mb[D + k]); Bv[k] = mb[k]; }
            __syncthreads();
            for (int rr = 0; rr < 16; rr += 2) {
                const int row = ch * 128 + wave * 16 + rr;
                const f32x4* xr0 = (const f32x4*)(x + (size_t)row * D) + lane; const f32x4* xr1 = xr0 + D / 4;
                f32x4 v0[8], v1[8]; float s0 = 0.f, s1 = 0.f;
#pragma unroll
                for (int j = 0; j < 8; ++j) { v0[j] = xr0[64 * j]; v1[j] = xr1[64 * j]; }
#pragma unroll
                for (int j = 0; j < 8; ++j) { s0 += (v0[j][0] * v0[j][0] + v0[j][1] * v0[j][1]) + (v0[j][2] * v0[j][2] + v0[j][3] * v0[j][3]);
                                              s1 += (v1[j][0] * v1[j][0] + v1[j][1] * v1[j][1]) + (v1[j][2] * v1[j][2] + v1[j][3] * v1[j][3]); }
                const float rstd0 = rsq(wave_sum(s0) * (1.0f / D) + EPS), rstd1 = rsq(wave_sum(s1) * (1.0f / D) + EPS);
                unsigned* o0 = (unsigned*)((unsigned char*)Hb + (size_t)row * D) + lane; unsigned* o1 = o0 + D / 4;
#pragma unroll
                for (int j = 0; j < 8; ++j) { const f32x4 a4 = *(const LAS f32x4*)(Av + 256 * j + 4 * lane), b4 = *(const LAS f32x4*)(Bv + 256 * j + 4 * lane);
                    const f32x4 h0 = (v0[j] * rstd0 * a4 + b4) * SC_H, h1 = (v1[j] * rstd1 * a4 + b4) * SC_H;
                    o0[64 * j] = pk4_fp8(h0[0], h0[1], h0[2], h0[3]); o1[64 * j] = pk4_fp8(h1[0], h1[1], h1[2], h1[3]); }
            }
        }
        __syncthreads();
    }
    SEAM(1);

    if (IN(2)) {
        KArgsP ap = kargs(); unsigned char* ws = ap->ws;
        WSP(bf16_t, WinT, WS_WINT); WSP(bf16_t, Hb, WS_H); WSP(bf16_t, Ub, WS_UBG); bf16_t* BAb = Ub + (size_t)T * DA; bf16_t* GLUb = BAb + (size_t)T * DA;
        pg8::DenseOrderG S; S.init(T, NPROJ, D, G, bx, WinT);
        pg8::EpiProj E{Ub, BAb, GLUb};
        pg8::gemm_phase<true, pg8::EpiProj, pg8::DenseOrderG>(lds, Hb, (unsigned)T * D, WinT, (unsigned)NPROJ * D, D, S, E);
    }
    SEAM(2);

    if (IN(3)) {
        KArgsP ap = kargs(); unsigned char* ws = ap->ws;
        const float* conv_a_w = ap->in[6]; const float* conv_b_w = ap->in[7]; const float* conv_b_b = ap->in[8];
        const float* ln_b_g = ap->in[9]; const float* ln_b_b = ap->in[10]; const float* hn_a_g = ap->in[11]; const float* hn_b_g = ap->in[12];
        WSP(bf16_t, Hb, WS_H); WSP(bf16_t, Ub, WS_UBG); bf16_t* BAb = Ub + (size_t)T * DA; bf16_t* GLUb = BAb + (size_t)T * DA;
        constexpr int CT = 32, NR = CT + 30, NRW = (NR + 7) / 8;
        LAS unsigned char* gt = lds;
        LAS unsigned short* zl = (LAS unsigned short*)(lds + 65536);
        static_assert(NR * 1024 <= 65536 && 65536 + CT * 1024 * 2 <= RING_BYTES, "P3 LDS map");
        constexpr int NCH = T / CT;
        u32x4 R[NRW];
#define P3_LOAD_TILE(chunk, pass) do { const int _t0 = (chunk) * CT, _tp = _t0 & (SEQ - 1); _Pragma("unroll") for (int _i = 0; _i < NRW; ++_i) { const int _r = wave + 8 * _i; \
            R[_i] = (u32x4){0u, 0u, 0u, 0u}; if (_r < NR && _tp - 30 + _r >= 0) R[_i] = *(const u32x4*)(GLUb + (size_t)(_t0 - 30 + _r) * DA + 512 * (pass) + 8 * lane); } } while (0)
#define P3_STORE_TILE() do { _Pragma("unroll") for (int _i = 0; _i < NRW; ++_i) { const int _r = wave + 8 * _i; if (_r < NR) *(LAS u32x4*)(gt + _r * 1024 + 16 * lane) = R[_i]; } } while (0)
#define P3_LOAD_W(pass) do { _Pragma("unroll") for (int _j = 0; _j < 31; ++_j) wv[_j] = __uint_as_float(__builtin_amdgcn_raw_buffer_load_b32(rsW, (tid + 512 * (pass)) * 4, _j * DA * 4, 0)); bias = conv_b_b[tid + 512 * (pass)]; } while (0)
#define P3_CONV(pass) do { float xv[NR]; _Pragma("unroll") for (int _i = 0; _i < NR; ++_i) xv[_i] = __uint_as_float(((unsigned)*(const LAS unsigned short*)(gt + _i * 1024 + 2 * tid)) << 16); \
            float _o[CT]; _Pragma("unroll") for (int _i = 0; _i < CT; ++_i) _o[_i] = bias; \
            _Pragma("unroll") for (int _j = 0; _j < 31; ++_j) _Pragma("unroll") for (int _i = 0; _i < CT; ++_i) _o[_i] = __builtin_fmaf(wv[_j], xv[_i + _j], _o[_i]);     \
            _Pragma("unroll") for (int _i = 0; _i < CT; ++_i) zl[_i * DA + tid + 512 * (pass)] = (unsigned short)pk2(_o[_i], 0.f); } while (0)
        float wv[31], bias;
        const __amdgpu_buffer_rsrc_t rsW = __builtin_amdgcn_make_buffer_rsrc((void*)conv_b_w, 0, 31 * DA * 4, 0x00020000);
        if (bx < NCH) { P3_LOAD_TILE(bx, 0); P3_STORE_TILE(); }
        for (int ch = bx; ch < NCH; ch += G) {
            const int t0 = ch * CT, tpos = t0 & (SEQ - 1), nxt = ch + G;
            P3_LOAD_W(0);
            __syncthreads();
            P3_LOAD_TILE(ch, 1);
            P3_CONV(0);
            P3_LOAD_W(1);
            __syncthreads();
            P3_STORE_TILE();
            __syncthreads();
            if (nxt < NCH) P3_LOAD_TILE(nxt, 0);
            P3_CONV(1);
            __syncthreads();
            if (nxt < NCH) P3_STORE_TILE();
            f32x4 lng[4], lnb[4], hnb[4], hna[4], cw0[4], cw1[4], cw2[4];
#pragma unroll
            for (int j = 0; j < 4; ++j) { const int c = 256 * j + 4 * lane;
                lng[j] = *(const f32x4*)(ln_b_g + c); lnb[j] = *(const f32x4*)(ln_b_b + c); hnb[j] = *(const f32x4*)(hn_b_g + c); hna[j] = *(const f32x4*)(hn_a_g + c);
                cw0[j] = *(const f32x4*)(conv_a_w + c); cw1[j] = *(const f32x4*)(conv_a_w + DA + c); cw2[j] = *(const f32x4*)(conv_a_w + 2 * DA + c); }
#pragma unroll 2
            for (int ii = 0; ii < CT / 8; ++ii) {
                const int i = (CT / 8) * wave + ii, t = t0 + i, tp = tpos + i;
                u32x2 pu0[4], pu1[4], pu2[4], pbb[4];
#pragma unroll
                for (int j = 0; j < 4; ++j) { const int c = 256 * j + 4 * lane;
                    pu0[j] = *(const u32x2*)(Ub + (size_t)t * DA + c); pbb[j] = *(const u32x2*)(BAb + (size_t)t * DA + c);
                    pu1[j] = (u32x2){0u, 0u}; pu2[j] = (u32x2){0u, 0u};
                    if (tp >= 1) pu1[j] = *(const u32x2*)(Ub + (size_t)(t - 1) * DA + c);
                    if (tp >= 2) pu2[j] = *(const u32x2*)(Ub + (size_t)(t - 2) * DA + c); }
                f32x4 z[4]; float s = 0.f;
#pragma unroll
                for (int j = 0; j < 4; ++j) { const u32x2 zq = *(const LAS u32x2*)(zl + i * DA + 256 * j + 4 * lane); z[j] = (f32x4){bflo(zq.x), bfhi(zq.x), bflo(zq.y), bfhi(zq.y)}; s += (z[j][0] + z[j][1]) + (z[j][2] + z[j][3]); }
                const float mean = wave_sum(s) * (1.0f / DA); float q = 0.f;
#pragma unroll
                for (int j = 0; j < 4; ++j) { z[j] = z[j] - mean; q += (z[j][0] * z[j][0] + z[j][1] * z[j][1]) + (z[j][2] * z[j][2] + z[j][3] * z[j][3]); }
                const float rstd = rsq(wave_sum(q) * (1.0f / DA) + EPS);
                bf16_t* yrow = Hb + (size_t)t * D;
#pragma unroll
                for (int j = 0; j < 4; ++j) {
                    f32x4 v = z[j] * rstd * lng[j] + lnb[j]; float ss = 0.f;
#pragma unroll
                    for (int e = 0; e < 4; ++e) { v[e] = v[e] * fast_sigmoid(v[e]); ss += v[e] * v[e]; }
                    ss = row_sum16(ss);
                    const float r = rsq(ss * (1.0f / 64.0f) + EPS);
                    const f32x4 o = v * r * hnb[j]; u32x2 w; w.x = pk2(o[0], o[1]); w.y = pk2(o[2], o[3]);
                    *(u32x2*)(yrow + DA + 256 * j + 4 * lane) = w;
                }
#pragma unroll
                for (int j = 0; j < 4; ++j) { const int c = 256 * j + 4 * lane;
                    const u32x2 u0 = pu0[j], u1 = pu1[j], u2 = pu2[j], bb = pbb[j];
                    f32x4 U0 = (f32x4){bflo(u0.x), bfhi(u0.x), bflo(u0.y), bfhi(u0.y)}, U1 = (f32x4){bflo(u1.x), bfhi(u1.x), bflo(u1.y), bfhi(u1.y)}, U2 = (f32x4){bflo(u2.x), bfhi(u2.x), bflo(u2.y), bfhi(u2.y)};
                    const f32x4 Bq = (f32x4){bflo(bb.x), bfhi(bb.x), bflo(bb.y), bfhi(bb.y)};
                    const f32x4 ya = Bq * (cw0[j] * U2 + cw1[j] * U1 + cw2[j] * U0);
                    float ss = (ya[0] * ya[0] + ya[1] * ya[1]) + (ya[2] * ya[2] + ya[3] * ya[3]);
                    ss = row_sum16(ss);
                    const float r = rsq(ss * (1.0f / 64.0f) + EPS);
                    const f32x4 o = ya * r * hna[j]; u32x2 w; w.x = pk2(o[0], o[1]); w.y = pk2(o[2], o[3]);
                    *(u32x2*)(yrow + c) = w; }
            }
        }
        __syncthreads();
    }
#undef P3_LOAD_TILE
#undef P3_STORE_TILE
#undef P3_LOAD_W
#undef P3_CONV
    SEAM(3);

    if (IN(4)) {
        KArgsP ap = kargs(); unsigned char* ws = ap->ws;
        const float* x = ap->in[0];
        WSP(float, mod, WS_MOD); WSP(float, ssq, WS_SSQ); WSP(bf16_t, WoutT, WS_WOUTT); WSP(bf16_t, Hb, WS_H); WSP(bf16_t, X2, WS_X2);
        pg8::DenseOrder S; S.init(T, D, D * 2, G, bx, WoutT);
        pg8::EpiOut E{x, mod, X2, ssq};
        pg8::gemm_phase<false, pg8::EpiOut, pg8::DenseOrder>(lds, Hb, (unsigned)T * D * 2, WoutT, (unsigned)D * D * 2, D * 2, S, E);
    }
    SEAM(4);

    if (IN(5)) {
        KArgsP ap = kargs(); unsigned char* ws = ap->ws;
        const float* norm_ffn_g = ap->in[14]; const float* router_bias = ap->in[16]; WSP(bf16_t, X2, WS_X2);
        WSP(float, mod, WS_MOD); WSP(float, ssq, WS_SSQ); WSP(int, tok_e, WS_TOKE); WSP(int, tok_r, WS_TOKR); WSP(float, tok_w, WS_TOKW); WSP(int, inv_tok, WS_INVT);
        WSP(bf16_t, WrThi, WS_WRT); bf16_t* WrTlo = WrThi + (size_t)NE * D; WSP(unsigned char, H2, WS_H2);
        unsigned* gcount = (unsigned*)(ws + WS_CTL) + CW_GCOUNT;
        LAS float* gsc = (LAS float*)lds; LAS float* shv = gsc + D;
        LAS unsigned char* slab = lds + 16384;
        LAS float* Sc = (LAS float*)(lds + 16384);
        LAS float* Mk = Sc + 128 * 65;
        LAS float* rbias = (LAS float*)(lds + 16384 + 65536 + 4096);
        LAS int* lcnt = (LAS int*)(rbias + 64); LAS int* lbase = lcnt + 64;
        for (int ch = bx; ch < T / 128; ch += G) {
            const int b = ch >> 4; const float* mb = mod + (size_t)b * (6 * D);
            __syncthreads();
            for (int k = tid; k < D; k += NTHR) { gsc[k] = norm_ffn_g[k] * (1.0f + mb[4 * D + k]); shv[k] = mb[3 * D + k]; }
            if (tid < NE) { rbias[tid] = router_bias[tid]; lcnt[tid] = 0; }
            __syncthreads();
            {
                const int r = lane & 15, q = lane >> 4, t = ch * 128 + wave * 16 + r;
                float s = 0.f;
#pragma unroll
                for (int p = 0; p < 8; ++p) s += ssq[(size_t)(q * 8 + p) * T + t];
                s += __shfl_xor(s, 16); s += __shfl_xor(s, 32);
                const float rstd = rsq(s * (1.0f / D) + EPS);
                f32x4 acc[4];
#pragma unroll
                for (int n = 0; n < 4; ++n) acc[n] = (f32x4){0.f, 0.f, 0.f, 0.f};
                const bf16_t* xrow = X2 + (size_t)t * D + 8 * q;
                unsigned char* hrow = H2 + (size_t)t * D + 8 * q;
                u32x4 xq[4];
#pragma unroll
                for (int s = 0; s < 4; ++s) xq[s] = *(const u32x4*)(xrow + 32 * s);
                unsigned sdst[4]; const bf16_t* ssrc[4];
#pragma unroll
                for (int j = 0; j < 4; ++j) { const int p = tid + 512 * j, hl = p >> 10, e = (p >> 4) & 63, kc = p & 15; const int ob = (e & 15) * 64 + (kc & 3) * 16;
                    sdst[j] = (unsigned)(((hl * 4 + (kc >> 2)) * 4 + (e >> 4)) * 1024 + (ob ^ (((ob >> 9) & 1) << 5))); ssrc[j] = (hl ? WrTlo : WrThi) + (size_t)e * D + 8 * kc; }
                const int fo = r * 64 + q * 16, foff = fo ^ (((fo >> 9) & 1) << 5);
                u32x4 sreg[4];
#pragma unroll
                for (int j = 0; j < 4; ++j) sreg[j] = *(const u32x4*)(ssrc[j]);
#pragma unroll
                for (int j = 0; j < 4; ++j) *(LAS u32x4*)(slab + sdst[j]) = sreg[j];
                __syncthreads();
#pragma unroll 1
                for (int k0 = 0; k0 < D; k0 += 128) {
                    const int it = k0 >> 7; LAS unsigned char* sb = slab + (it & 1) * 32768;
                    const int kn = (k0 + 128 < D) ? k0 + 128 : k0;
#pragma unroll
                    for (int j = 0; j < 4; ++j) sreg[j] = *(const u32x4*)(ssrc[j] + kn);
#pragma unroll
                    for (int s = 0; s < 4; ++s) {
                        const int kk = k0 + 32 * s;
                        const f32x4 ga = *(const LAS f32x4*)(gsc + kk + 8 * q), gb = *(const LAS f32x4*)(gsc + kk + 8 * q + 4);
                        const f32x4 sa = *(const LAS f32x4*)(shv + kk + 8 * q), sb4 = *(const LAS f32x4*)(shv + kk + 8 * q + 4);
                        const f32x4 xa4 = (f32x4){bflo(xq[s].x), bfhi(xq[s].x), bflo(xq[s].y), bfhi(xq[s].y)}, xb4 = (f32x4){bflo(xq[s].z), bfhi(xq[s].z), bflo(xq[s].w), bfhi(xq[s].w)};
                        const f32x4 ha = xa4 * rstd * ga + sa, hb = xb4 * rstd * gb + sb4;
                        const int kx = (kk + 128 < D) ? kk + 128 : kk;
                        xq[s] = *(const u32x4*)(xrow + kx);
                        u32x4 ph, pl;
                        ph.x = pk2(ha[0], ha[1]); ph.y = pk2(ha[2], ha[3]); ph.z = pk2(hb[0], hb[1]); ph.w = pk2(hb[2], hb[3]);
                        pl.x = pk2(ha[0] - bflo(ph.x), ha[1] - bfhi(ph.x)); pl.y = pk2(ha[2] - bflo(ph.y), ha[3] - bfhi(ph.y));
                        pl.z = pk2(hb[0] - bflo(ph.z), hb[1] - bfhi(ph.z)); pl.w = pk2(hb[2] - bflo(ph.w), hb[3] - bfhi(ph.w));
                        { u32x2 h8; h8.x = pk4_fp8(ha[0] * SC_H2, ha[1] * SC_H2, ha[2] * SC_H2, ha[3] * SC_H2); h8.y = pk4_fp8(hb[0] * SC_H2, hb[1] * SC_H2, hb[2] * SC_H2, hb[3] * SC_H2); *(u32x2*)(hrow + kk) = h8; }
                        const bf16x8 Ah = __builtin_bit_cast(bf16x8, ph), Al = __builtin_bit_cast(bf16x8, pl);
#pragma unroll
                        for (int n = 0; n < 4; ++n) {
                            const bf16x8 Bh = *(const LAS bf16x8*)(sb + ((0 * 4 + s) * 4 + n) * 1024 + foff), Bl = *(const LAS bf16x8*)(sb + ((1 * 4 + s) * 4 + n) * 1024 + foff);
                            acc[n] = __builtin_amdgcn_mfma_f32_16x16x32_bf16(Bh, Ah, acc[n], 0, 0, 0);
                            acc[n] = __builtin_amdgcn_mfma_f32_16x16x32_bf16(Bl, Ah, acc[n], 0, 0, 0);
                            acc[n] = __builtin_amdgcn_mfma_f32_16x16x32_bf16(Bh, Al, acc[n], 0, 0, 0);
                        }
                    }
#pragma unroll
                    for (int j = 0; j < 4; ++j) *(LAS u32x4*)(slab + ((it + 1) & 1) * 32768 + sdst[j]) = sreg[j];
                    __syncthreads();
                }
#pragma unroll
                for (int n = 0; n < 4; ++n)
#pragma unroll
                    for (int i = 0; i < 4; ++i) Sc[(wave * 16 + r) * 65 + 16 * n + 4 * q + i] = 1.0f / (1.0f + expf(-acc[n][i]));
            }
            __syncthreads();
            int idx[TOPK]; float wk[TOPK]; int lr[TOPK];
            const int tl = tid;
            if (tid < 128) {
                LAS float* srow = Sc + tl * 65; LAS float* mrow = Mk + tl * 65;
                float gs[8];
#pragma unroll
                for (int g = 0; g < 8; ++g) { float m1 = -INFINITY, m2 = -INFINITY;
#pragma unroll
                    for (int j = 0; j < 8; ++j) { const float v = srow[8 * g + j] + rbias[8 * g + j]; mrow[8 * g + j] = v; if (v > m1) { m2 = m1; m1 = v; } else if (v > m2) m2 = v; }
                    gs[g] = m1 + m2; }
                unsigned sel = 0u;
#pragma unroll
                for (int g = 0; g < 8; ++g) { int rank = 0;
#pragma unroll
                    for (int h = 0; h < 8; ++h) rank += (gs[h] > gs[g] || (gs[h] == gs[g] && h < g)) ? 1 : 0;
                    if (rank < 4) sel |= 1u << g; }
#pragma unroll
                for (int g = 0; g < 8; ++g) if (!((sel >> g) & 1u)) {
#pragma unroll
                    for (int j = 0; j < 8; ++j) mrow[8 * g + j] = -INFINITY; }
                float wsum = 0.f;
#pragma unroll
                for (int k = 0; k < TOPK; ++k) { float best = -INFINITY; int bi = 0;
#pragma unroll 8
                    for (int e = 0; e < NE; ++e) { const float v = mrow[e]; if (v > best) { best = v; bi = e; } }
                    mrow[bi] = -INFINITY; idx[k] = bi; wk[k] = srow[bi]; wsum += wk[k]; }
                const float inv = 2.5f / wsum;
#pragma unroll
                for (int k = 0; k < TOPK; ++k) { wk[k] *= inv; lr[k] = atomicAdd((int*)&lcnt[idx[k]], 1); }
            }
            __syncthreads();
            if (tid < NE) lbase[tid] = (int)atomicAdd(&gcount[tid], (unsigned)lcnt[tid]);
            __syncthreads();
            if (tid < 128) { const int t = ch * 128 + tl;
#pragma unroll
                for (int k = 0; k < TOPK; ++k) { const int e = idx[k], rank = lbase[e] + lr[k];
                    tok_e[t * 8 + k] = e; tok_r[t * 8 + k] = rank; tok_w[t * 8 + k] = wk[k]; inv_tok[e * T + rank] = t; }
                inv_tok[NE * T + t] = t; }
        }
        __syncthreads();
    }
    SEAM(5);

    if (IN(6)) {
        KArgsP ap = kargs(); unsigned char* ws = ap->ws;
        WSP(int, inv_tok, WS_INVT); WSP(unsigned char, W1T, WS_W1T); WSP(unsigned char, H2, WS_H2); WSP(unsigned char, ACT, WS_ACT);
        unsigned* gcount = (unsigned*)(ws + WS_CTL) + CW_GCOUNT;
        int NBr; build_tables(lds, gcount, NBr);
        pg8::MoeOrder<0, 4> S; S.blk_e = lds + TBL_BLKE; S.blkstart = (const LAS int*)(lds + TBL_BSTART); S.cnt = (const LAS int*)(lds + TBL_CNT);
        S.NB = NBr + 128; S.G = G; S.vcu = vcu; S.KB = D; S.Bt = W1T; S.estride = 1024u * D; S.boff0 = 0; S.inv_tok = inv_tok;
        pg8::EpiAct E{ACT};
        pg8::gemm_phase<true, pg8::EpiAct, pg8::MoeOrder<0, 4>>(lds, H2, (unsigned)T * D, W1T, 65u * 1024u * D, D, S, E);
    }
    SEAM(6);

    if (IN(7)) {
        KArgsP ap = kargs(); unsigned char* ws = ap->ws;
        WSP(int, inv_tok, WS_INVT); WSP(unsigned char, W2T, WS_W2T); WSP(unsigned char, ACT, WS_ACT); WSP(unsigned char, YR, WS_Y);
        unsigned* gcount = (unsigned*)(ws + WS_CTL) + CW_GCOUNT;
        int NBr; build_tables(lds, gcount, NBr);
        pg8::MoeOrder<1, 8> S; S.blk_e = lds + TBL_BLKE; S.blkstart = (const LAS int*)(lds + TBL_BSTART); S.cnt = (const LAS int*)(lds + TBL_CNT);
        S.NB = NBr + 128; S.G = G; S.vcu = vcu; S.KB = FE; S.Bt = W2T; S.estride = (unsigned)D * FE; S.boff0 = 0; S.inv_tok = inv_tok;
        pg8::EpiY8 E{YR};
        pg8::gemm_phase<true, pg8::EpiY8, pg8::MoeOrder<1, 8>>(lds, ACT, (unsigned)MAXBLK * 256 * FE, W2T, 65u * D * FE, FE, S, E);
    }
    SEAM(7);

    if (IN(8)) {
        KArgsP ap = kargs(); unsigned char* ws = ap->ws;
        const float* norm_final_g = ap->in[23]; float* out = ap->out;
        WSP(float, mod, WS_MOD); WSP(int, tok_e, WS_TOKE); WSP(int, tok_r, WS_TOKR); WSP(float, tok_w, WS_TOKW); WSP(unsigned char, YR, WS_Y); WSP(bf16_t, X2, WS_X2);
        unsigned* gcount = (unsigned*)(ws + WS_CTL) + CW_GCOUNT;
        int NBr; build_tables(lds, gcount, NBr);
        const LAS int* blkstart = (const LAS int*)(lds + TBL_BSTART);
        const int tstride = G * NWAVES;
        for (int t0 = vcu * NWAVES + wave; t0 < T; t0 += 2 * tstride) {
            int tt[2]; tt[0] = t0; tt[1] = (t0 + tstride < T) ? t0 + tstride : t0;
            f32x4 a[2][4][2];
#pragma unroll
            for (int u = 0; u < 2; ++u)
#pragma unroll
                for (int j = 0; j < 4; ++j) { a[u][j][0] = (f32x4){0.f, 0.f, 0.f, 0.f}; a[u][j][1] = (f32x4){0.f, 0.f, 0.f, 0.f}; }
#pragma unroll 3
            for (int k = 0; k < TOPK + 1; ++k) {
#pragma unroll
                for (int u = 0; u < 2; ++u) { const int t = tt[u];
                    int row; float w; constexpr float ys = 1.0f / SC_Y;
                    if (k < TOPK) { const int e = tok_e[t * 8 + k]; row = 256 * blkstart[e] + tok_r[t * 8 + k]; w = tok_w[t * 8 + k] * ys; } else { row = 256 * NBr + t; w = ys; }
                    const unsigned char* yr = YR + (size_t)row * D + 8 * lane;
#pragma unroll
                    for (int j = 0; j < 4; ++j) { const u32x2 y2 = *(const u32x2*)(yr + 512 * j);
                        const f32x2 p0 = __builtin_amdgcn_cvt_pk_f32_fp8((int)y2.x, false), p1 = __builtin_amdgcn_cvt_pk_f32_fp8((int)y2.x, true);
                        const f32x2 p2 = __builtin_amdgcn_cvt_pk_f32_fp8((int)y2.y, false), p3 = __builtin_amdgcn_cvt_pk_f32_fp8((int)y2.y, true);
                        a[u][j][0] = a[u][j][0] + w * (f32x4){p0.x, p0.y, p1.x, p1.y}; a[u][j][1] = a[u][j][1] + w * (f32x4){p2.x, p2.y, p3.x, p3.y}; } }
            }
#pragma unroll
            for (int u = 0; u < 2; ++u) { const int t = tt[u]; const int b = t >> 11; const float* gf = mod + (size_t)b * (6 * D) + 5 * D;
                float* orow = out + (size_t)t * D; const bf16_t* xrow = X2 + (size_t)t * D;
                float ss = 0.f;
#pragma unroll
                for (int j = 0; j < 4; ++j) { const u32x4 xq = *(const u32x4*)(xrow + 512 * j + 8 * lane);
#pragma unroll
                    for (int h = 0; h < 2; ++h) { const int c = 512 * j + 8 * lane + 4 * h; const unsigned q0 = h ? xq.z : xq.x, q1 = h ? xq.w : xq.y;
                        const f32x4 xv = (f32x4){bflo(q0), bfhi(q0), bflo(q1), bfhi(q1)}, g4 = *(const f32x4*)(gf + c);
                        a[u][j][h] = xv + g4 * a[u][j][h]; ss += (a[u][j][h][0] * a[u][j][h][0] + a[u][j][h][1] * a[u][j][h][1]) + (a[u][j][h][2] * a[u][j][h][2] + a[u][j][h][3] * a[u][j][h][3]); } }
                const float rstd = rsq(wave_sum(ss) * (1.0f / D) + EPS);
#pragma unroll
                for (int j = 0; j < 4; ++j)
#pragma unroll
                    for (int h = 0; h < 2; ++h) { const int c = 512 * j + 8 * lane + 4 * h; const f32x4 g0 = *(const f32x4*)(norm_final_g + c); *(f32x4*)(orow + c) = a[u][j][h] * rstd * g0; }
            }
        }
    }
#undef IN
#undef SEAM
}

extern "C" void kernel_launch(void* const* d_in, const int* in_sizes, int n_in, void* d_out, int out_size, void* d_ws, size_t ws_size, hipStream_t stream) {
    static int grid = 0;
    if (grid == 0) {
        if (n_in != 24 || out_size != T * D || ws_size < WS_END) { fprintf(stderr, "kernel_launch: unexpected problem (n_in %d, out %d, ws %zu)\n", n_in, out_size, ws_size); grid = -1; return; }
        int dev = 0, cus = 0, per_cu = 0;
        if (hipGetDevice(&dev) != hipSuccess || hipDeviceGetAttribute(&cus, hipDeviceAttributeMultiprocessorCount, dev) != hipSuccess) { grid = -1; return; }
        if (hipFuncSetAttribute((const void*)fwd_kernel, hipFuncAttributeMaxDynamicSharedMemorySize, LDS_BYTES) != hipSuccess) { fprintf(stderr, "kernel_launch: hipFuncSetAttribute failed\n"); grid = -1; return; }
        if (hipOccupancyMaxActiveBlocksPerMultiprocessor(&per_cu, (const void*)fwd_kernel, NTHR, LDS_BYTES) != hipSuccess || per_cu < 1) { fprintf(stderr, "kernel_launch: occupancy query says %d\n", per_cu); }
        (void)hipGetLastError();
        grid = cus;
    }
    if (grid < 0) return;
    (void)hipMemsetAsync((char*)d_ws + WS_CTL, 0, CTL_ZERO_BYTES, stream);
    Args a{};
    for (int i = 0; i < 24; ++i) a.in[i] = (const float*)d_in[i];
    a.out = (float*)d_out; a.ws = (unsigned char*)d_ws;
    constexpr int NPH = 9;
    if (MK_N_LAUNCHES == 1) {
        a.ph_lo = 0; a.ph_hi = NPH;
        hipLaunchKernelGGL(fwd_kernel, dim3(grid), dim3(NTHR), LDS_BYTES, stream, a);
    } else {
        for (int p = 0; p < NPH; ++p) { const int reps = ((REPEAT_MASK >> p) & 1) ? 2 : 1;
            for (int r = 0; r < reps; ++r) { if (p == 5 && r > 0) (void)hipMemsetAsync((char*)d_ws + WS_CTL + CW_GCOUNT * 4, 0, 256, stream);
                a.ph_lo = p; a.ph_hi = p + 1; hipLaunchKernelGGL(fwd_kernel, dim3(grid), dim3(NTHR), LDS_BYTES, stream, a); } }
    }
}
```

```cpp
#include <hip/hip_runtime.h>
#include <cstdio>
#include <cstdint>

#ifndef MK_N_LAUNCHES
#define MK_N_LAUNCHES 1
#endif
#ifndef REPEAT_MASK
#define REPEAT_MASK 0
#endif

#define GAS __attribute__((address_space(1)))
#define LAS __attribute__((address_space(3)))
typedef unsigned short bf16_t;
typedef short bf16x8 __attribute__((ext_vector_type(8)));
typedef float f32x4 __attribute__((ext_vector_type(4)));
typedef float f32x2 __attribute__((ext_vector_type(2)));
typedef unsigned u32x4 __attribute__((ext_vector_type(4)));
typedef unsigned u32x2 __attribute__((ext_vector_type(2)));

constexpr int T = 32768, D = 2048, NB_ = 16, SEQ = 2048, NE = 64, FE = 512, NPROJ = 5120, TOPK = 8;
constexpr int DA = 1024;
constexpr float EPS = 1e-6f;
constexpr int NWAVES = 8, NTHR = 512;
constexpr int MAXBLK = 1215;

constexpr size_t MiB = 1u << 20;
constexpr size_t WS_CTL = 0, CTL_ZERO_BYTES = 1 * MiB;
constexpr size_t WS_MOD = 1 * MiB;
constexpr size_t WS_SSQ = 2 * MiB;
constexpr size_t WS_TOKE = 6 * MiB;
constexpr size_t WS_TOKR = 7 * MiB;
constexpr size_t WS_TOKW = 8 * MiB;
constexpr size_t WS_INVT = 9 * MiB;
constexpr size_t WS_WRT = 18 * MiB;
constexpr size_t WS_W2T = 32 * MiB;
constexpr size_t WS_ACT = 162 * MiB;
constexpr size_t WS_X2 = 320 * MiB;
constexpr size_t WS_UBG = 162 * MiB;
constexpr size_t WS_Y = 466 * MiB;
constexpr size_t WS_W1T = 466 * MiB;
constexpr size_t WS_WINT = 726 * MiB;
constexpr size_t WS_WOUTT = 746 * MiB;
constexpr size_t WS_H2 = 754 * MiB;
constexpr size_t WS_H = 882 * MiB;
constexpr size_t WS_END = 1074 * MiB;
static_assert(WS_Y + (size_t)MAXBLK * 256 * 2048 <= WS_END, "ws map");
static_assert(WS_ACT + (size_t)MAXBLK * 256 * 512 * 2 <= WS_Y, "ws map");
constexpr int CW_BAR = 4096;
constexpr int CW_GCOUNT = 8192;

constexpr int RING_BYTES = 131072;
constexpr int TBL_OFF = RING_BYTES;
constexpr int TBL_BLKE = TBL_OFF, TBL_BSTART = TBL_OFF + 1280, TBL_CNT = TBL_BSTART + 66 * 4 + 8;
constexpr int MISC_OFF = RING_BYTES + 4096;
constexpr int GATH_OFF = RING_BYTES + 4096 + 256;
constexpr int LDS_BYTES = 147456;
static_assert(GATH_OFF + 8192 <= LDS_BYTES, "LDS map");
static_assert(TBL_CNT + 64 * 4 <= MISC_OFF && MISC_OFF + 128 <= LDS_BYTES, "LDS map");

__device__ __forceinline__ unsigned f2bf(float f) { unsigned u = __builtin_bit_cast(unsigned, f); return (u + 0x7fffu + ((u >> 16) & 1u)) >> 16; }
__device__ __forceinline__ float bflo(unsigned w) { return __uint_as_float(w << 16); }
__device__ __forceinline__ float bfhi(unsigned w) { return __uint_as_float(w & 0xffff0000u); }
template <int CTRL> __device__ __forceinline__ float dpp_mov(float v) { return __builtin_bit_cast(float, __builtin_amdgcn_update_dpp(0, __builtin_bit_cast(int, v), CTRL, 0xF, 0xF, true)); }
__device__ __forceinline__ float row_sum16(float v) {
    v += dpp_mov<0xB1>(v); v += dpp_mov<0x4E>(v); v += dpp_mov<0x141>(v); v += dpp_mov<0x140>(v); return v; }
__device__ __forceinline__ float rdlane(float v, int l) { return __builtin_bit_cast(float, __builtin_amdgcn_readlane(__builtin_bit_cast(int, v), l)); }
__device__ __forceinline__ float wave_sum(float v) { v = row_sum16(v); return (rdlane(v, 0) + rdlane(v, 16)) + (rdlane(v, 32) + rdlane(v, 48)); }
__device__ __forceinline__ float fast_sigmoid(float x) { return __builtin_amdgcn_rcpf(1.0f + __builtin_amdgcn_exp2f(-1.44269504089f * x)); }
constexpr float SC_H = 16.0f, SC_WI = 512.0f;
constexpr float SC_YM = 16.0f, SC_WO = 512.0f;
constexpr float SC_H2 = 16.0f, SC_W1 = 512.0f, SC_ACT = 8.0f, SC_W2 = 4.0f, SC_Y = SC_ACT * SC_W2;
__device__ __forceinline__ float clamp448(float v) { return __builtin_amdgcn_fmed3f(v, -448.0f, 448.0f); }
__device__ __forceinline__ unsigned pk4_fp8(float a, float b, float c, float d) {
    int r = __builtin_amdgcn_cvt_pk_fp8_f32(clamp448(a), clamp448(b), 0, false);
    r = __builtin_amdgcn_cvt_pk_fp8_f32(clamp448(c), clamp448(d), r, true);
    return (unsigned)r;
}
typedef int i32x8 __attribute__((ext_vector_type(8)));
typedef int i32x4v __attribute__((ext_vector_type(4)));
__device__ __forceinline__ unsigned cvt_pk_bf16(float lo, float hi) { unsigned r; asm volatile("v_cvt_pk_bf16_f32 %0, %1, %2" : "=v"(r) : "v"(lo), "v"(hi)); return r; }
__device__ __forceinline__ unsigned pk2(float lo, float hi) { unsigned r; asm("v_cvt_pk_bf16_f32 %0, %1, %2" : "=v"(r) : "v"(lo), "v"(hi)); return r; }
__device__ __forceinline__ float rsq(float x) { return __builtin_amdgcn_rsqf(x); }

#define XB_TMO      128
#define XB_XCNT(j)  (256  + 64 * (j))
#define XB_XSUB(j)  (1280 + 64 * (j))
#define XB_XGEN(j)  (2304 + 64 * (j))
#define XB_TOP      3328
#define XB_TOPGEN   3392
#define XCD_BAR_WORDS 3456
#define XB_SPIN_CAP (1u << 18)
__device__ __forceinline__ unsigned xb_ld(unsigned* p)              { return __hip_atomic_load(p, __ATOMIC_RELAXED, __HIP_MEMORY_SCOPE_AGENT); }
__device__ __forceinline__ unsigned xb_add(unsigned* p, unsigned v) { return __hip_atomic_fetch_add(p, v, __ATOMIC_RELAXED, __HIP_MEMORY_SCOPE_AGENT); }
__device__ __forceinline__ unsigned xb_xcc_id() { return (unsigned)__builtin_amdgcn_s_getreg((3 << 11) | 20) & 0xFu; }
#define XB_SPIN(cond, bar) do { unsigned _sp = 0; while (cond) { __builtin_amdgcn_s_sleep(1); \
    if ((++_sp & 255u) == 0u) { if (xb_ld(&(bar)[XB_TMO])) break; if (_sp > XB_SPIN_CAP) { atomicAdd(&(bar)[XB_TMO], 1u); break; } } } } while (0)
struct XcdBarrier { unsigned* bar; unsigned x; volatile LAS unsigned* st; };
__device__ __forceinline__ XcdBarrier xcd_barrier_post(unsigned* bar, volatile LAS unsigned* st) {
    XcdBarrier b; b.bar = bar; b.x = xb_xcc_id(); b.st = st;
    if (threadIdx.x == 0) (void)xb_add(&bar[XB_XCNT(b.x)], 1u);
    return b;
}
__device__ __forceinline__ void xcd_barrier_complete(unsigned* bar, unsigned x, unsigned& nloc, unsigned& nx) {
    const unsigned G = gridDim.x * gridDim.y * gridDim.z;
    unsigned sum, cnt, mine, sp = 0u;
    for (;;) {
        sum = 0u; cnt = 0u; mine = 0u;
#pragma unroll
        for (unsigned j = 0; j < 16; ++j) { const unsigned c = xb_ld(&bar[XB_XCNT(j)]); sum += c; cnt += (c > 0u) ? 1u : 0u; mine = (j == x) ? c : mine; }
        if (sum == G) break;
        __builtin_amdgcn_s_sleep(1);
        if ((++sp & 255u) == 0u) { if (xb_ld(&bar[XB_TMO])) break; if (sp > XB_SPIN_CAP) { atomicAdd(&bar[XB_TMO], 1u); break; } }
    }
    nloc = mine > 0u ? mine : 1u; nx = cnt > 0u ? cnt : 1u;
}
__device__ __forceinline__ void xcd_barrier(const XcdBarrier& b) {
    asm volatile("s_waitcnt vmcnt(0)" ::: "memory");
    __syncthreads();
    if (threadIdx.x == 0) {
        unsigned* bar = b.bar;
        __builtin_amdgcn_s_waitcnt(0);
        unsigned nloc = b.st[0], nx = b.st[1];
        if (nloc == 0u) { xcd_barrier_complete(bar, b.x, nloc, nx); b.st[0] = nloc; b.st[1] = nx; }
        const unsigned old = xb_add(&bar[XB_XSUB(b.x)], 1u);
        const unsigned gen = old / nloc;
        if (old + 1u == (gen + 1u) * nloc) {
            __builtin_amdgcn_fence(__ATOMIC_RELEASE, "agent");
            asm volatile("s_waitcnt vmcnt(0)" ::: "memory");
            const unsigned og = xb_add(&bar[XB_TOP], 1u);
            const unsigned tg = og / nx;
            if (og + 1u == (tg + 1u) * nx) xb_add(&bar[XB_TOPGEN], 1u);
            else XB_SPIN(xb_ld(&bar[XB_TOPGEN]) == tg, bar);
            __builtin_amdgcn_fence(__ATOMIC_ACQUIRE, "agent");
            xb_add(&bar[XB_XGEN(b.x)], 1u);
            asm volatile("s_waitcnt vmcnt(0)" ::: "memory");
        } else {
            XB_SPIN(xb_ld(&bar[XB_XGEN(b.x)]) == gen, bar);
            __builtin_amdgcn_fence(__ATOMIC_ACQUIRE, "agent");
            asm volatile("s_waitcnt vmcnt(0)" ::: "memory");
        }
    }
    __syncthreads();
}

namespace pg8 {
constexpr int BM = 256, BK = 64, HALF = 128, HTB = HALF * BK * 2, STAGE_BYTES = 8 * HTB;
__host__ __device__ __forceinline__ int lds_byte(int r, int c) { const int st = (r >> 4) * 2 + (c >> 5), rr = r & 15, cc = c & 31, ob = rr * 64 + cc * 2; return st * 1024 + (ob ^ (((ob >> 9) & 1) << 5)); }
__host__ __device__ __forceinline__ void stage_rc(int b, int& R, int& C) { const int st = b / 1024, sb = b % 1024, swz = sb ^ (((sb >> 9) & 1) << 5); R = (st >> 1) * 16 + swz / 64; C = (st & 1) * 32 + (swz % 64) / 2; }
__host__ __device__ __forceinline__ int perm32(int rho) { const int n = rho >> 4, i = rho & 15; return 8 * (i >> 2) + 4 * n + (i & 3); }

struct Unit { int pm, pn, e; };

struct DenseOrder {
    static constexpr bool GATHER = false;
    int nM, nN, nwg, G, c, KB; const void* Bt;
    __device__ void init(int M, int N, int KB_, int G_, int c_, const void* Bt_) { nM = M / BM; nN = N / BM; nwg = nM * nN; G = G_; c = c_; KB = KB_; Bt = Bt_; }
    __device__ __forceinline__ bool next(int i, Unit& u) const {
        const long L = (long)i * G + c; if (L >= nwg) return false;
        int wgid = (int)L; { const int q = nwg / 8, r = nwg % 8, xcd = wgid % 8, off = wgid / 8; wgid = (xcd < r ? xcd * (q + 1) : r * (q + 1) + (xcd - r) * q) + off; }
        const int nig = 8 * nN, gid = wgid / nig, fm = gid * 8, gsz = (nM - fm) < 8 ? (nM - fm) : 8;
        u.pm = fm + ((wgid % nig) % gsz); u.pn = (wgid % nig) / gsz; u.e = 0; return true;
    }
    __device__ __forceinline__ unsigned b_off(const Unit& u) const { return (unsigned)u.pn * (256u * (unsigned)KB); }
    __device__ __forceinline__ unsigned a_unit_off(const Unit& u) const { return (unsigned)u.pm * (256u * (unsigned)KB); }
    __device__ __forceinline__ void prefetch_rows(const Unit&, LAS unsigned char*, int, int, int) const {}
    __device__ __forceinline__ void fetch_rows(const Unit&, LAS unsigned char*, int, int, int, int, unsigned (&)[2][2]) const {}
};
struct DenseOrderG : DenseOrder {
    static constexpr bool GATHER = true;
    __device__ __forceinline__ unsigned a_unit_off(const Unit&) const { return 0u; }
    __device__ __forceinline__ void fetch_rows(const Unit& u, LAS unsigned char*, int, int, int R0, int C0, unsigned (&v)[2][2]) const {
#pragma unroll
        for (int h = 0; h < 2; ++h)
#pragma unroll
            for (int i = 0; i < 2; ++i) v[h][i] = (unsigned)(u.pm * 256 + 128 * h + R0 + 64 * i) * (unsigned)KB + 2u * C0;
    }
};
template <int MODE, int NPN> struct MoeOrder {
    static constexpr bool GATHER = true;
    const LAS unsigned char* blk_e; const LAS int* blkstart; const LAS int* cnt;
    int NB, G, vcu, KB; const void* Bt; unsigned estride, boff0; const int* inv_tok;
    __device__ __forceinline__ bool next(int i, Unit& u) const {
        const int L = i * G + vcu, grp = L / (8 * NPN), w = L % (8 * NPN), rb = grp * 8 + (w & 7);
        if (rb >= NB) return false;
        u.pm = rb; u.pn = w >> 3; u.e = __builtin_amdgcn_readfirstlane((int)blk_e[rb]); return true;
    }
    __device__ __forceinline__ unsigned b_off(const Unit& u) const { return (unsigned)u.e * estride + boff0 + (unsigned)u.pn * (256u * (unsigned)KB); }
    __device__ __forceinline__ unsigned a_unit_off(const Unit& u) const { return 0u; }
    __device__ __forceinline__ void prefetch_rows(const Unit& u, LAS unsigned char* slots, int wid, int lane, int R0) const {
        if (MODE == 0) {
            const int lb = u.pm - __builtin_amdgcn_readfirstlane(blkstart[u.e]);
            const int n = (u.e < NE) ? __builtin_amdgcn_readfirstlane(cnt[u.e]) : T;
            const int* src = inv_tok + (size_t)u.e * T;
#pragma unroll
            for (int h = 0; h < 2; ++h)
#pragma unroll
                for (int i = 0; i < 2; ++i) { int rank = lb * 256 + 128 * h + R0 + 64 * i; rank = rank < n ? rank : n - 1;
                    __builtin_amdgcn_global_load_lds((const unsigned*)(src + rank), (LAS unsigned*)(slots + wid * 1024 + (h * 2 + i) * 256), 4, 0, 0); }
        }
    }
    __device__ __forceinline__ void fetch_rows(const Unit& u, LAS unsigned char* slots, int wid, int lane, int R0, int C0, unsigned (&v)[2][2]) const {
#pragma unroll
        for (int h = 0; h < 2; ++h)
#pragma unroll
            for (int i = 0; i < 2; ++i) {
                int row;
                if (MODE == 0) row = ((const LAS int*)(slots + wid * 1024 + (h * 2 + i) * 256))[lane]; else row = u.pm * 256 + 128 * h + R0 + 64 * i;
                v[h][i] = (unsigned)row * (unsigned)KB + 2u * C0; }
    }
};


struct EpiProj {
    static constexpr int BHALF_ROWS = 128;
    static __device__ __forceinline__ int brow(int R) { return (R & ~31) + perm32(R & 31); }
    bf16_t* U; bf16_t* BA; bf16_t* GLU;
    __device__ __forceinline__ void operator()(const f32x4 (&acc)[2][2][4][2], const Unit& u, int wr, int wc, int fr, int fq) const {
        const int row0 = u.pm * BM + wr * 64 + fr, pn = u.pn;
        if (pn >= 8 && pn < 12) {
            const int col0 = 256 * (pn - 8) + wc * 32 + 8 * fq;
#pragma unroll
            for (int ai = 0; ai < 2; ++ai)
#pragma unroll
                for (int m = 0; m < 4; ++m) { bf16_t* rowp = BA + (size_t)(row0 + ai * HALF + m * 16) * DA + col0;
#pragma unroll
                    for (int bj = 0; bj < 2; ++bj) { constexpr float sp = 1.0f / (SC_H * SC_WI); const f32x4 v0 = acc[ai][bj][m][0] * sp, v1 = acc[ai][bj][m][1] * sp;
                        u32x4 w; w.x = cvt_pk_bf16(v0[0], v0[1]); w.y = cvt_pk_bf16(v0[2], v0[3]); w.z = cvt_pk_bf16(v1[0], v1[1]); w.w = cvt_pk_bf16(v1[2], v1[3]);
                        *(u32x4*)(rowp + bj * HALF) = w; } }
        } else {
            const bool isu = pn < 8; bf16_t* base = isu ? U : GLU; const int col0 = 128 * (isu ? pn : pn - 12) + wc * 32 + 8 * fq;
#pragma unroll
            for (int ai = 0; ai < 2; ++ai)
#pragma unroll
                for (int m = 0; m < 4; ++m) { bf16_t* rowp = base + (size_t)(row0 + ai * HALF + m * 16) * DA + col0;
                    constexpr float sp = 1.0f / (SC_H * SC_WI);
                    f32x4 a0 = acc[ai][0][m][0] * sp, a1 = acc[ai][0][m][1] * sp; const f32x4 b0 = acc[ai][1][m][0] * sp, b1 = acc[ai][1][m][1] * sp;
                    if (isu) { a0 = a0 * b0; a1 = a1 * b1; }
                    else {
#pragma unroll
                        for (int j = 0; j < 4; ++j) { a0[j] = a0[j] * fast_sigmoid(b0[j]); a1[j] = a1[j] * fast_sigmoid(b1[j]); } }
                    u32x4 w; w.x = cvt_pk_bf16(a0[0], a0[1]); w.y = cvt_pk_bf16(a0[2], a0[3]); w.z = cvt_pk_bf16(a1[0], a1[1]); w.w = cvt_pk_bf16(a1[2], a1[3]);
                    *(u32x4*)rowp = w; }
        }
    }
};
struct EpiOut {
    static constexpr int BHALF_ROWS = 128;
    static __device__ __forceinline__ int brow(int R) { return (R & ~31) + perm32(R & 31); }
    const float* x; const float* mod; bf16_t* x2; float* ssq;
    __device__ __forceinline__ void operator()(const f32x4 (&acc)[2][2][4][2], const Unit& u, int wr, int wc, int fr, int fq) const {
        const int row0 = u.pm * BM + wr * 64 + fr, col0 = u.pn * BM + wc * 32 + 8 * fq;
        const float* gm = mod + (size_t)(u.pm >> 3) * (6 * D) + 2 * D;
        f32x4 gv[2][2];
#pragma unroll
        for (int bj = 0; bj < 2; ++bj)
#pragma unroll
            for (int n = 0; n < 2; ++n) gv[bj][n] = *(const f32x4*)(gm + col0 + bj * HALF + 4 * n);
#pragma unroll
        for (int ai = 0; ai < 2; ++ai)
#pragma unroll
          for (int mp = 0; mp < 2; ++mp) {
            f32x4 xv[2][2][2];
#pragma unroll
            for (int mm = 0; mm < 2; ++mm)
#pragma unroll
                for (int bj = 0; bj < 2; ++bj)
#pragma unroll
                    for (int n = 0; n < 2; ++n) xv[mm][bj][n] = *(const f32x4*)(x + (size_t)(row0 + ai * HALF + (2 * mp + mm) * 16) * D + col0 + bj * HALF + 4 * n);
            asm volatile("" ::: "memory");
#pragma unroll
            for (int mm = 0; mm < 2; ++mm) { const int m = 2 * mp + mm; const int row = row0 + ai * HALF + m * 16; const size_t off = (size_t)row * D + col0; float s = 0.f;
#pragma unroll
                for (int bj = 0; bj < 2; ++bj) { constexpr float so = 1.0f / (SC_YM * SC_WO); const f32x4 o0 = xv[mm][bj][0] + gv[bj][0] * (acc[ai][bj][m][0] * so), o1 = xv[mm][bj][1] + gv[bj][1] * (acc[ai][bj][m][1] * so);
                    u32x4 w; w.x = pk2(o0[0], o0[1]); w.y = pk2(o0[2], o0[3]); w.z = pk2(o1[0], o1[1]); w.w = pk2(o1[2], o1[3]);
                    *(u32x4*)(x2 + off + bj * HALF) = w;
                    const float r0 = bflo(w.x), r1 = bfhi(w.x), r2 = bflo(w.y), r3 = bfhi(w.y), r4 = bflo(w.z), r5 = bfhi(w.z), r6 = bflo(w.w), r7 = bfhi(w.w);
                    s += ((r0 * r0 + r1 * r1) + (r2 * r2 + r3 * r3)) + ((r4 * r4 + r5 * r5) + (r6 * r6 + r7 * r7)); }
                s += __shfl_xor(s, 16); s += __shfl_xor(s, 32);
                if (fq == 0) ssq[(size_t)(u.pn * 4 + wc) * T + row] = s; }
            asm volatile("" ::: "memory");
          }
    }
};
struct EpiAct {
    static constexpr int BHALF_ROWS = 128;
    static __device__ __forceinline__ int brow(int R) { return (R & ~31) + perm32(R & 31); }
    unsigned char* act;
    __device__ __forceinline__ void operator()(const f32x4 (&acc)[2][2][4][2], const Unit& u, int wr, int wc, int fr, int fq) const {
        const int row0 = u.pm * BM + wr * 64 + fr, col0 = 128 * u.pn + wc * 32 + 8 * fq;
#pragma unroll
        for (int ai = 0; ai < 2; ++ai)
#pragma unroll
            for (int m = 0; m < 4; ++m) { unsigned char* rowp = act + (size_t)(row0 + ai * HALF + m * 16) * FE + col0;
                constexpr float s1 = 1.0f / (SC_H2 * SC_W1), s2 = SC_ACT / (SC_H2 * SC_W1);
                f32x4 a0 = acc[ai][0][m][0] * s1, a1 = acc[ai][0][m][1] * s1; const f32x4 b0 = acc[ai][1][m][0] * s2, b1 = acc[ai][1][m][1] * s2;
#pragma unroll
                for (int j = 0; j < 4; ++j) { a0[j] = a0[j] * fast_sigmoid(a0[j]) * b0[j]; a1[j] = a1[j] * fast_sigmoid(a1[j]) * b1[j]; }
                u32x2 w; w.x = pk4_fp8(a0[0], a0[1], a0[2], a0[3]); w.y = pk4_fp8(a1[0], a1[1], a1[2], a1[3]);
                *(u32x2*)rowp = w; }
    }
};
struct EpiY8 {
    static constexpr int BHALF_ROWS = 8;
    static __device__ __forceinline__ int brow(int R) { return 64 * (R >> 5) + 16 * ((R & 15) >> 2) + 4 * ((R >> 4) & 1) + (R & 3); }
    unsigned char* Y;
    __device__ __forceinline__ void operator()(const f32x4 (&acc)[2][2][4][2], const Unit& u, int wr, int wc, int fr, int fq) const {
        const int row0 = u.pm * BM + wr * 64 + fr, col0 = u.pn * BM + 64 * wc + 16 * fq;
        static_assert(SC_Y == SC_ACT * SC_W2, "y rows are stored unscaled");
#pragma unroll
        for (int ai = 0; ai < 2; ++ai)
#pragma unroll
            for (int m = 0; m < 4; ++m) { unsigned char* rowp = Y + (size_t)(row0 + ai * HALF + m * 16) * D + col0;
                const f32x4 v0 = acc[ai][0][m][0], v1 = acc[ai][0][m][1], v2 = acc[ai][1][m][0], v3 = acc[ai][1][m][1];
                u32x4 w; w.x = pk4_fp8(v0[0], v0[1], v0[2], v0[3]); w.y = pk4_fp8(v1[0], v1[1], v1[2], v1[3]); w.z = pk4_fp8(v2[0], v2[1], v2[2], v2[3]); w.w = pk4_fp8(v3[0], v3[1], v3[2], v3[3]);
                __builtin_nontemporal_store(w, (u32x4*)rowp); }
    }
};

template <bool FP8, class Epi, class Sched>
__device__ __forceinline__ void gemm_phase(LAS unsigned char* lds, const void* A, unsigned abytes, const void* Bt, unsigned bbytes, const int KB_, const Sched& S, const Epi& E) {
    int KB = KB_; asm volatile("" : "+s"(KB));
    const int tid = threadIdx.x, wid = __builtin_amdgcn_readfirstlane(tid >> 6), lane = tid & 63, wr = wid >> 2, wc = wid & 3, fr = lane & 15, fq = lane >> 4;
    const int nt = KB / 128;
    int R0, C0; stage_rc(tid * 16, R0, C0);
    unsigned voffB[2], vd[2];
#pragma unroll
    for (int i = 0; i < 2; ++i) { const int R = R0 + 64 * i; const int Rb = Epi::brow(R); voffB[i] = (unsigned)Rb * (unsigned)KB + 2u * C0; vd[i] = (unsigned)R * (unsigned)KB + 2u * C0; }
    constexpr bool GA = Sched::GATHER;
    LAS unsigned char* slots = lds + GATH_OFF;
    const __amdgpu_buffer_rsrc_t rsA = __builtin_amdgcn_make_buffer_rsrc((void*)A, 0, (int)abytes, 0x00020000);
    const __amdgpu_buffer_rsrc_t rsB = __builtin_amdgcn_make_buffer_rsrc((void*)Bt, 0, (int)bbytes, 0x00020000);
    const unsigned kstep = 128u;
    const unsigned hstep = (unsigned)HALF * (unsigned)KB;
    const unsigned hstepB = (unsigned)Epi::BHALF_ROWS * (unsigned)KB;
    const unsigned ldsw = (unsigned)wid * 1024u;
    const int aoff = lds_byte(wr * 64 + fr, fq * 8), boff = lds_byte(wc * 32 + fr, fq * 8);
#define PG8_SA(b, h) (((b) * 2 + (h)) * HTB)
#define PG8_SB(b, h) ((4 + (b) * 2 + (h)) * HTB)
#define PG8_STAGE(bufoff, rs, soff, voff) do { _Pragma("unroll") for (int _i = 0; _i < 2; ++_i) \
        __builtin_amdgcn_raw_ptr_buffer_load_lds(rs, (LAS void*)(lds + (bufoff) + ldsw + _i * 8192), 16, (int)(voff)[_i], (int)(soff), 0, 0); } while (0)
#define PG8_STAGE_A(bufoff, so, h) do { if constexpr (GA) PG8_STAGE(bufoff, rsA, so, vc[h]); else PG8_STAGE(bufoff, rsA, (so) + (h) * hstep, vd); } while (0)
#define PG8_LDA(dst, b, h) do { _Pragma("unroll") for (int m = 0; m < 4; ++m) { \
        if constexpr (FP8) { const i32x4v _lo = *(const LAS i32x4v*)(lds + PG8_SA(b, h) + aoff + m * 2048), _hi = *(const LAS i32x4v*)(lds + PG8_SA(b, h) + aoff + m * 2048 + 1024); \
            dst##8[m] = __builtin_shufflevector(_lo, _hi, 0, 1, 2, 3, 4, 5, 6, 7); } \
        else { _Pragma("unroll") for (int k = 0; k < 2; ++k) dst[m][k] = *(const LAS bf16x8*)(lds + PG8_SA(b, h) + aoff + m * 2048 + k * 1024); } } } while (0)
#define PG8_LDB(dst, b, h) do { _Pragma("unroll") for (int n = 0; n < 2; ++n) { \
        if constexpr (FP8) { const i32x4v _lo = *(const LAS i32x4v*)(lds + PG8_SB(b, h) + boff + n * 2048), _hi = *(const LAS i32x4v*)(lds + PG8_SB(b, h) + boff + n * 2048 + 1024); \
            dst##8[n] = __builtin_shufflevector(_lo, _hi, 0, 1, 2, 3, 4, 5, 6, 7); } \
        else { _Pragma("unroll") for (int k = 0; k < 2; ++k) dst[n][k] = *(const LAS bf16x8*)(lds + PG8_SB(b, h) + boff + n * 2048 + k * 1024); } } } while (0)
#define PG8_MMA(ai, bj, At, Bt) do { __builtin_amdgcn_s_setprio(1); _Pragma("unroll") for (int m = 0; m < 4; ++m) _Pragma("unroll") for (int n = 0; n < 2; ++n) { \
        if constexpr (FP8) { acc[ai][bj][m][n] = __builtin_amdgcn_mfma_scale_f32_16x16x128_f8f6f4(Bt##8[n], At##8[m], acc[ai][bj][m][n], 0, 0, 0, 0x7F7F7F7F, 0, 0x7F7F7F7F); } \
        else { _Pragma("unroll") for (int k = 0; k < 2; ++k) acc[ai][bj][m][n] = __builtin_amdgcn_mfma_f32_16x16x32_bf16(Bt[n][k], At[m][k], acc[ai][bj][m][n], 0, 0, 0); } } \
        __builtin_amdgcn_s_setprio(0); } while (0)
#define PG8_WAIT_V(n) asm volatile("s_waitcnt vmcnt(" #n ")" ::: "memory")
#define PG8_WAIT_L(n) asm volatile("s_waitcnt lgkmcnt(" #n ")" ::: "memory")
#define PG8_BAR __builtin_amdgcn_s_barrier()
#define PG8_SCHED __builtin_amdgcn_sched_barrier(0)
    Unit cur, nxt; int ui = 0;
    if (!S.next(0, cur)) return;
    f32x4 acc[2][2][4][2];
#pragma unroll
    for (int a = 0; a < 2; ++a)
#pragma unroll
        for (int b = 0; b < 2; ++b)
#pragma unroll
            for (int m = 0; m < 4; ++m)
#pragma unroll
                for (int n = 0; n < 2; ++n) acc[a][b][m][n] = (f32x4){0.f, 0.f, 0.f, 0.f};
    bf16x8 At[4][2], B0[2][2], B1[2][2];
    i32x8 At8[4], B08[2], B18[2];
    unsigned cA = S.a_unit_off(cur), cB = S.b_off(cur);
    unsigned vc[2][2] = {{0u, 0u}, {0u, 0u}};
    if constexpr (GA) { S.prefetch_rows(cur, slots, wid, lane, R0); PG8_WAIT_V(0); S.fetch_rows(cur, slots, wid, lane, R0, C0, vc); PG8_WAIT_L(0); }
    PG8_STAGE(PG8_SB(0, 0), rsB, cB, voffB); PG8_STAGE(PG8_SB(0, 1), rsB, cB + hstepB, voffB); PG8_STAGE_A(PG8_SA(0, 0), cA, 0); PG8_STAGE_A(PG8_SA(0, 1), cA, 1);
    if (wr == 1) PG8_BAR;
    PG8_WAIT_V(2); PG8_BAR;
    PG8_STAGE(PG8_SB(1, 0), rsB, cB + kstep, voffB); PG8_STAGE_A(PG8_SA(1, 0), cA + kstep, 0); PG8_STAGE(PG8_SB(1, 1), rsB, cB + hstepB + kstep, voffB);
    PG8_WAIT_V(6); PG8_BAR;
    for (;;) {
        const bool has_next = S.next(ui + 1, nxt);
        unsigned nB = cB, nA = cA;
        if (has_next) { nB = S.b_off(nxt); nA = S.a_unit_off(nxt); if constexpr (GA) S.prefetch_rows(nxt, slots, wid, lane, R0); }
#pragma unroll 1
        for (int t = 0; t < nt; t += 2) {
            const bool last = (t == nt - 2);
            const unsigned a1 = cA + (unsigned)(t + 1) * kstep;
            const unsigned a2 = last ? nA : cA + (unsigned)(t + 2) * kstep, b2 = last ? nB : cB + (unsigned)(t + 2) * kstep;
            const unsigned a3 = a2 + kstep, b3 = b2 + kstep;
            PG8_LDB(B0, 0, 0); PG8_LDB(B1, 0, 1); PG8_SCHED; PG8_LDA(At, 0, 0); PG8_STAGE_A(PG8_SA(1, 1), a1, 1);
            if constexpr (GA) { if (last && has_next) S.fetch_rows(nxt, slots, wid, lane, R0, C0, vc); }
            PG8_WAIT_V(8); PG8_WAIT_L(0); PG8_BAR; PG8_MMA(0, 0, At, B0); PG8_MMA(0, 1, At, B1); PG8_BAR; PG8_SCHED;
            PG8_LDA(At, 0, 1); PG8_STAGE(PG8_SB(0, 0), rsB, b2, voffB); PG8_STAGE(PG8_SB(0, 1), rsB, b2 + hstepB, voffB); PG8_STAGE_A(PG8_SA(0, 0), a2, 0);
            PG8_WAIT_V(8); PG8_WAIT_L(0); PG8_BAR; PG8_MMA(1, 0, At, B0); PG8_MMA(1, 1, At, B1); PG8_BAR; PG8_SCHED;
            PG8_LDB(B0, 1, 0); PG8_LDB(B1, 1, 1); PG8_SCHED; PG8_LDA(At, 1, 0); PG8_STAGE_A(PG8_SA(0, 1), a2, 1);
            PG8_WAIT_V(8); PG8_WAIT_L(0); PG8_BAR; PG8_MMA(0, 0, At, B0); PG8_MMA(0, 1, At, B1); PG8_BAR; PG8_SCHED;
            PG8_LDA(At, 1, 1); PG8_STAGE(PG8_SB(1, 0), rsB, b3, voffB); PG8_STAGE(PG8_SB(1, 1), rsB, b3 + hstepB, voffB); PG8_STAGE_A(PG8_SA(1, 0), a3, 0);
            PG8_WAIT_V(8); PG8_WAIT_L(0); PG8_BAR; PG8_MMA(1, 0, At, B0); PG8_MMA(1, 1, At, B1); PG8_BAR; PG8_SCHED;
        }
        if (wr == 0) PG8_BAR;
        E(acc, cur, wr, wc, fr, fq);
        if (!has_next) break;
#pragma unroll
        for (int a = 0; a < 2; ++a)
#pragma unroll
            for (int b = 0; b < 2; ++b)
#pragma unroll
                for (int m = 0; m < 4; ++m)
#pragma unroll
                    for (int n = 0; n < 2; ++n) acc[a][b][m][n] = (f32x4){0.f, 0.f, 0.f, 0.f};
        cur = nxt; cB = nB; cA = nA; ++ui;
        if (wr == 1) PG8_BAR;
    }
    PG8_WAIT_V(0);
    PG8_BAR;
#undef PG8_SA
#undef PG8_SB
#undef PG8_STAGE
#undef PG8_STAGE_A
#undef PG8_LDA
#undef PG8_LDB
#undef PG8_MMA
#undef PG8_WAIT_V
#undef PG8_WAIT_L
#undef PG8_BAR
#undef PG8_SCHED
}
}

struct Args { const float* in[24]; float* out; unsigned char* ws; int ph_lo, ph_hi; };

__device__ __forceinline__ void p0_transpose_item(const float* W, int K, int N, bf16_t* WT, int k0, int n0, int rowbase, LAS float* scr, int lane) {
#pragma unroll 8
    for (int i = 0; i < 32; ++i) { const int kk = 2 * i + (lane >> 5); scr[kk * 33 + (lane & 31)] = W[(size_t)(k0 + kk) * N + n0 + (lane & 31)]; }
    asm volatile("s_waitcnt lgkmcnt(0)" ::: "memory");
    const int c = lane & 7;
#pragma unroll
    for (int j = 0; j < 4; ++j) { const int n = (lane >> 3) + 8 * j; const LAS float* s = scr + (8 * c) * 33 + n;
        u32x4 o; o.x = pk2(s[0 * 33], s[1 * 33]); o.y = pk2(s[2 * 33], s[3 * 33]); o.z = pk2(s[4 * 33], s[5 * 33]); o.w = pk2(s[6 * 33], s[7 * 33]);
        *(u32x4*)(WT + (size_t)(rowbase + n) * K + k0 + 8 * c) = o; }
    asm volatile("s_waitcnt lgkmcnt(0)" ::: "memory");
}
__device__ __forceinline__ void p0_transpose_item_fp8(const float* W, int K, int N, unsigned char* WT, int k0, int n0, int rowbase, float sc, LAS float* scr, int lane) {
#pragma unroll 8
    for (int i = 0; i < 32; ++i) { const int kk = 2 * i + (lane >> 5); scr[kk * 33 + (lane & 31)] = W[(size_t)(k0 + kk) * N + n0 + (lane & 31)]; }
    asm volatile("s_waitcnt lgkmcnt(0)" ::: "memory");
    const int c = lane & 7;
#pragma unroll
    for (int j = 0; j < 4; ++j) { const int n = (lane >> 3) + 8 * j; const LAS float* s = scr + (8 * c) * 33 + n;
        u32x2 o; o.x = pk4_fp8(s[0 * 33] * sc, s[1 * 33] * sc, s[2 * 33] * sc, s[3 * 33] * sc); o.y = pk4_fp8(s[4 * 33] * sc, s[5 * 33] * sc, s[6 * 33] * sc, s[7 * 33] * sc);
        *(u32x2*)(WT + (size_t)(rowbase + n) * K + k0 + 8 * c) = o; }
    asm volatile("s_waitcnt lgkmcnt(0)" ::: "memory");
}
__device__ __forceinline__ void p0_router_item(const float* W, bf16_t* WThi, bf16_t* WTlo, int k0, int n0, LAS float* scr, int lane) {
    constexpr int K = D, N = NE;
#pragma unroll 8
    for (int i = 0; i < 32; ++i) { const int kk = 2 * i + (lane >> 5); scr[kk * 33 + (lane & 31)] = W[(size_t)(k0 + kk) * N + n0 + (lane & 31)]; }
    asm volatile("s_waitcnt lgkmcnt(0)" ::: "memory");
    const int c = lane & 7;
#pragma unroll
    for (int j = 0; j < 4; ++j) { const int n = (lane >> 3) + 8 * j; const LAS float* s = scr + (8 * c) * 33 + n;
        unsigned hi[8], lo[8];
#pragma unroll
        for (int q = 0; q < 8; ++q) { const float v = s[q * 33]; hi[q] = f2bf(v); lo[q] = f2bf(v - __uint_as_float(hi[q] << 16)); }
        u32x4 oh, ol; oh.x = hi[0] | (hi[1] << 16); oh.y = hi[2] | (hi[3] << 16); oh.z = hi[4] | (hi[5] << 16); oh.w = hi[6] | (hi[7] << 16);
        ol.x = lo[0] | (lo[1] << 16); ol.y = lo[2] | (lo[3] << 16); ol.z = lo[4] | (lo[5] << 16); ol.w = lo[6] | (lo[7] << 16);
        *(u32x4*)(WThi + (size_t)(n0 + n) * K + k0 + 8 * c) = oh; *(u32x4*)(WTlo + (size_t)(n0 + n) * K + k0 + 8 * c) = ol; }
    asm volatile("s_waitcnt lgkmcnt(0)" ::: "memory");
}
__device__ __forceinline__ int win_rowbase(int n0) {
    if (n0 < 1024) return 256 * (n0 >> 7) + (n0 & 127);
    if (n0 < 2048) return 2048 + (n0 - 1024);
    if (n0 < 3072) { const int n = n0 - 2048; return 256 * (n >> 7) + 128 + (n & 127); }
    if (n0 < 4096) { const int n = n0 - 3072; return 3072 + 256 * (n >> 7) + (n & 127); }
    { const int n = n0 - 4096; return 3072 + 256 * (n >> 7) + 128 + (n & 127); }
}

__device__ __forceinline__ void build_tables(LAS unsigned char* lds, const unsigned* gcount, int& NBr) {
    LAS unsigned char* blk_e = lds + TBL_BLKE; LAS int* blkstart = (LAS int*)(lds + TBL_BSTART); LAS int* cnt = (LAS int*)(lds + TBL_CNT);
    const int tid = threadIdx.x;
    __syncthreads();
    if (tid < NE) cnt[tid] = (int)gcount[tid];
    __syncthreads();
    if (tid == 0) { int s = 0; for (int e = 0; e < NE; ++e) { blkstart[e] = s; s += (cnt[e] + 255) >> 8; } blkstart[NE] = s; }
    __syncthreads();
    NBr = blkstart[NE];
    if (tid < NE) { const int b0 = blkstart[tid], nb = (cnt[tid] + 255) >> 8; for (int i = 0; i < nb; ++i) blk_e[b0 + i] = (unsigned char)tid; }
    if (tid >= 64 && tid < 64 + 128) blk_e[NBr + tid - 64] = (unsigned char)NE;
    __syncthreads();
}


typedef const __attribute__((address_space(4))) Args* KArgsP;
__device__ __forceinline__ KArgsP kargs() { KArgsP p = (KArgsP)__builtin_amdgcn_kernarg_segment_ptr(); asm volatile("" : "+s"(p)); return p; }
#define WSP(type, name, off) type* name = (type*)(ws + (off))
__global__ void __launch_bounds__(NTHR, 2) fwd_kernel(Args args) {
    extern __shared__ __attribute__((aligned(16))) unsigned char lds_raw[];
    LAS unsigned char* lds = (LAS unsigned char*)lds_raw;
    volatile LAS unsigned* MISC = (volatile LAS unsigned*)(lds + MISC_OFF);
    const int tid = threadIdx.x, lane = tid & 63, wave = __builtin_amdgcn_readfirstlane(tid >> 6);
    const int G = gridDim.x, bx = blockIdx.x;
    const int vcu = (G % 8 == 0) ? (bx % 8) * (G / 8) + bx / 8 : bx;
    unsigned* ctl = (unsigned*)(args.ws + WS_CTL);
    for (int u = tid; u < (LDS_BYTES - MISC_OFF) / 4; u += NTHR) ((LAS unsigned*)(lds + MISC_OFF))[u] = 0u;
    __syncthreads();
    XcdBarrier bar; bar.bar = ctl + CW_BAR; bar.x = 0; bar.st = nullptr;
    if (MK_N_LAUNCHES == 1) bar = xcd_barrier_post(ctl + CW_BAR, MISC + 8);
    const int lo = args.ph_lo, hi = args.ph_hi;
#ifndef PH_MASK
#define PH_MASK 0x1ff
#endif
#define IN(k) ((((PH_MASK) >> (k)) & 1) && lo <= (k) && (k) < hi)
#define SEAM(k) do { if (IN(k) && IN((k) + 1)) xcd_barrier(bar); } while (0)

    if (IN(0)) {
        KArgsP ap = kargs(); unsigned char* ws = ap->ws;
        const float* cvec = ap->in[1]; const float* w_ada = ap->in[2]; const float* b_ada = ap->in[3];
        WSP(float, mod, WS_MOD);
        {
            LAS float* cs = (LAS float*)lds;
            for (int it = bx; it < 192; it += G) {
                __syncthreads();
                for (int i = tid; i < NB_ * D; i += NTHR) { const float v = cvec[i]; cs[i] = v / (1.0f + expf(-v)); }
                __syncthreads();
                const int n0 = 64 * it, cg = tid & 15, rl = tid >> 4;
                float a[16][4];
#pragma unroll
                for (int b = 0; b < 16; ++b) { a[b][0] = 0.f; a[b][1] = 0.f; a[b][2] = 0.f; a[b][3] = 0.f; }
#pragma unroll 2
                for (int kk = rl; kk < D; kk += 32) {
                    const f32x4 w4 = *(const f32x4*)(w_ada + (size_t)kk * (6 * D) + n0 + 4 * cg);
#pragma unroll
                    for (int b = 0; b < 16; ++b) { const float s = cs[b * D + kk]; a[b][0] += s * w4[0]; a[b][1] += s * w4[1]; a[b][2] += s * w4[2]; a[b][3] += s * w4[3]; }
                }
#pragma unroll
                for (int b = 0; b < 16; ++b)
#pragma unroll
                    for (int c = 0; c < 4; ++c) { float v = a[b][c]; v += __shfl_xor(v, 16); v += __shfl_xor(v, 32); a[b][c] = v; }
                __syncthreads();
                LAS float* red = (LAS float*)lds;
                if (lane < 16) {
#pragma unroll
                    for (int b = 0; b < 16; ++b)
#pragma unroll
                        for (int c = 0; c < 4; ++c) red[(wave * 16 + b) * 64 + 4 * cg + c] = a[b][c];
                }
                __syncthreads();
                for (int o = tid; o < 16 * 64; o += NTHR) { const int b = o >> 6, c = o & 63; float s = b_ada[n0 + c];
#pragma unroll
                    for (int w = 0; w < 8; ++w) s += red[(w * 16 + b) * 64 + c];
                    mod[(size_t)b * (6 * D) + n0 + c] = s; }
            }
            __syncthreads();
        }
        {
            const float* w_in = ap->in[5]; const float* w_out = ap->in[13]; const float* w_router = ap->in[15];
            const float* w_gate = ap->in[17]; const float* w_up = ap->in[18]; const float* w_down = ap->in[19];
            const float* ws_gate = ap->in[20]; const float* ws_up = ap->in[21]; const float* ws_down = ap->in[22];
            WSP(bf16_t, WrThi, WS_WRT); bf16_t* WrTlo = WrThi + (size_t)NE * D;
            WSP(unsigned char, W2T, WS_W2T); WSP(unsigned char, W1T, WS_W1T); WSP(bf16_t, WinT, WS_WINT); WSP(bf16_t, WoutT, WS_WOUTT);
            LAS float* scr = (LAS float*)(lds + wave * 16384);
            const int gw = vcu * NWAVES + wave, NGW = G * NWAVES;
            constexpr int I_IN = 32 * 160, I_OUT = 32 * 64, I_GU = 32 * 16, I_DN = 8 * 64, I_RT = 32 * 2;
            constexpr int NITEMS = I_IN + I_OUT + 65 * 2 * I_GU + 65 * I_DN + I_RT;
            for (int it = gw; it < NITEMS; it += NGW) {
                int r = it;
                if (r < I_IN) { const int kb = r / 160, nb = r % 160; p0_transpose_item_fp8(w_in, D, NPROJ, (unsigned char*)WinT, 64 * kb, 32 * nb, win_rowbase(32 * nb), SC_WI, scr, lane); continue; } r -= I_IN;
                if (r < I_OUT) { const int kb = r / 64, nb = r % 64; p0_transpose_item_fp8(w_out, D, D, (unsigned char*)WoutT, 64 * kb, 32 * nb, 32 * nb, SC_WO, scr, lane); continue; } r -= I_OUT;
                if (r < 65 * 2 * I_GU) { const int e = r / (2 * I_GU), r2 = r % (2 * I_GU), isup = r2 / I_GU, r3 = r2 % I_GU, kb = r3 / 16, nb = r3 % 16, n0 = 32 * nb;
                    const float* W = (e < NE) ? ((isup ? w_up : w_gate) + (size_t)e * D * FE) : (isup ? ws_up : ws_gate);
                    p0_transpose_item_fp8(W, D, FE, W1T + (size_t)e * 1024 * D, 64 * kb, n0, 256 * (n0 >> 7) + 128 * isup + (n0 & 127), SC_W1, scr, lane); continue; } r -= 65 * 2 * I_GU;
                if (r < 65 * I_DN) { const int e = r / I_DN, r3 = r % I_DN, kb = r3 / 64, nb = r3 % 64;
                    const float* W = (e < NE) ? (w_down + (size_t)e * FE * D) : ws_down;
                    p0_transpose_item_fp8(W, FE, D, W2T + (size_t)e * D * FE, 64 * kb, 32 * nb, 32 * nb, SC_W2, scr, lane); continue; } r -= 65 * I_DN;
                { const int kb = r / 2, nb = r % 2; p0_router_item(w_router, WrThi, WrTlo, 64 * kb, 32 * nb, scr, lane); }
            }
        }
    }
    SEAM(0);

    if (IN(1)) {
        KArgsP ap = kargs(); unsigned char* ws = ap->ws;
        const float* x = ap->in[0]; const float* norm_mix_g = ap->in[4];
        WSP(float, mod, WS_MOD); WSP(bf16_t, Hb, WS_H);
        LAS float* Av = (LAS float*)lds; LAS float* Bv = Av + D;
        for (int ch = bx; ch < T / 128; ch += G) {
            const int b = ch >> 4; const float* mb = mod + (size_t)b * (6 * D);
            __syncthreads();
            for (int k = tid; k < D; k += NTHR) { Av[k] = norm_mix_g[k] * (1.0f + mb[D + k]); Bv[k] = mb[k]; }
            __syncthreads();
            for (int rr = 0; rr < 16; rr += 2) {
                const int row = ch * 128 + wave * 16 + rr;
                const f32x4* xr0 = (const f32x4*)(x + (size_t)row * D) + lane; const f32x4* xr1 = xr0 + D / 4;
                f32x4 v0[8], v1[8]; float s0 = 0.f, s1 = 0.f;
#pragma unroll
                for (int j = 0; j < 8; ++j) { v0[j] = xr0[64 * j]; v1[j] = xr1[64 * j]; }
#pragma unroll
                for (int j = 0; j < 8; ++j) { s0 += (v0[j][0] * v0[j][0] + v0[j][1] * v0[j][1]) + (v0[j][2] * v0[j][2] + v0[j][3] * v0[j][3]);
                                              s1 += (v1[j][0] * v1[j][0] + v1[j][1] * v1[j][1]) + (v1[j][2] * v1[j][2] + v1[j][3] * v1[j][3]); }
                const float rstd0 = rsq(wave_sum(s0) * (1.0f / D) + EPS), rstd1 = rsq(wave_sum(s1) * (1.0f / D) + EPS);
                unsigned* o0 = (unsigned*)((unsigned char*)Hb + (size_t)row * D) + lane; unsigned* o1 = o0 + D / 4;
#pragma unroll
                for (int j = 0; j < 8; ++j) { const f32x4 a4 = *(const LAS f32x4*)(Av + 256 * j + 4 * lane), b4 = *(const LAS f32x4*)(Bv + 256 * j + 4 * lane);
                    const f32x4 h0 = (v0[j] * rstd0 * a4 + b4) * SC_H, h1 = (v1[j] * rstd1 * a4 + b4) * SC_H;
                    o0[64 * j] = pk4_fp8(h0[0], h0[1], h0[2], h0[3]); o1[64 * j] = pk4_fp8(h1[0], h1[1], h1[2], h1[3]); }
            }
        }
        __syncthreads();
    }
    SEAM(1);

    if (IN(2)) {
        KArgsP ap = kargs(); unsigned char* ws = ap->ws;
        WSP(bf16_t, WinT, WS_WINT); WSP(bf16_t, Hb, WS_H); WSP(bf16_t, Ub, WS_UBG); bf16_t* BAb = Ub + (size_t)T * DA; bf16_t* GLUb = BAb + (size_t)T * DA;
        pg8::DenseOrderG S; S.init(T, NPROJ, D, G, bx, WinT);
        pg8::EpiProj E{Ub, BAb, GLUb};
        pg8::gemm_phase<true, pg8::EpiProj, pg8::DenseOrderG>(lds, Hb, (unsigned)T * D, WinT, (unsigned)NPROJ * D, D, S, E);
    }
    SEAM(2);

    if (IN(3)) {
        KArgsP ap = kargs(); unsigned char* ws = ap->ws;
        const float* conv_a_w = ap->in[6]; const float* conv_b_w = ap->in[7]; const float* conv_b_b = ap->in[8];
        const float* ln_b_g = ap->in[9]; const float* ln_b_b = ap->in[10]; const float* hn_a_g = ap->in[11]; const float* hn_b_g = ap->in[12];
        WSP(bf16_t, Hb, WS_H); WSP(bf16_t, Ub, WS_UBG); bf16_t* BAb = Ub + (size_t)T * DA; bf16_t* GLUb = BAb + (size_t)T * DA;
        constexpr int CT = 32, NR = CT + 30, NRW = (NR + 7) / 8;
        LAS unsigned char* gt = lds;
        LAS unsigned short* zl = (LAS unsigned short*)(lds + 65536);
        static_assert(NR * 1024 <= 65536 && 65536 + CT * 1024 * 2 <= RING_BYTES, "P3 LDS map");
        constexpr int NCH = T / CT;
        u32x4 R[NRW];
#define P3_LOAD_TILE(chunk, pass) do { const int _t0 = (chunk) * CT, _tp = _t0 & (SEQ - 1); _Pragma("unroll") for (int _i = 0; _i < NRW; ++_i) { const int _r = wave + 8 * _i; \
            R[_i] = (u32x4){0u, 0u, 0u, 0u}; if (_r < NR && _tp - 30 + _r >= 0) R[_i] = *(const u32x4*)(GLUb + (size_t)(_t0 - 30 + _r) * DA + 512 * (pass) + 8 * lane); } } while (0)
#define P3_STORE_TILE() do { _Pragma("unroll") for (int _i = 0; _i < NRW; ++_i) { const int _r = wave + 8 * _i; if (_r < NR) *(LAS u32x4*)(gt + _r * 1024 + 16 * lane) = R[_i]; } } while (0)
#define P3_LOAD_W(pass) do { _Pragma("unroll") for (int _j = 0; _j < 31; ++_j) wv[_j] = __uint_as_float(__builtin_amdgcn_raw_buffer_load_b32(rsW, (tid + 512 * (pass)) * 4, _j * DA * 4, 0)); bias = conv_b_b[tid + 512 * (pass)]; } while (0)
#define P3_CONV(pass) do { float xv[NR]; _Pragma("unroll") for (int _i = 0; _i < NR; ++_i) xv[_i] = __uint_as_float(((unsigned)*(const LAS unsigned short*)(gt + _i * 1024 + 2 * tid)) << 16); \
            float _o[CT]; _Pragma("unroll") for (int _i = 0; _i < CT; ++_i) _o[_i] = bias; \
            _Pragma("unroll") for (int _j = 0; _j < 31; ++_j) _Pragma("unroll") for (int _i = 0; _i < CT; ++_i) _o[_i] = __builtin_fmaf(wv[_j], xv[_i + _j], _o[_i]);     \
            _Pragma("unroll") for (int _i = 0; _i < CT; ++_i) zl[_i * DA + tid + 512 * (pass)] = (unsigned short)pk2(_o[_i], 0.f); } while (0)
        float wv[31], bias;
        const __amdgpu_buffer_rsrc_t rsW = __builtin_amdgcn_make_buffer_rsrc((void*)conv_b_w, 0, 31 * DA * 4, 0x00020000);
        if (bx < NCH) { P3_LOAD_TILE(bx, 0); P3_STORE_TILE(); }
        for (int ch = bx; ch < NCH; ch += G) {
            const int t0 = ch * CT, tpos = t0 & (SEQ - 1), nxt = ch + G;
            P3_LOAD_W(0);
            __syncthreads();
            P3_LOAD_TILE(ch, 1);
            P3_CONV(0);
            P3_LOAD_W(1);
            __syncthreads();
            P3_STORE_TILE();
            __syncthreads();
            if (nxt < NCH) P3_LOAD_TILE(nxt, 0);
            P3_CONV(1);
            __syncthreads();
            if (nxt < NCH) P3_STORE_TILE();
            f32x4 lng[4], lnb[4], hnb[4], hna[4], cw0[4], cw1[4], cw2[4];
#pragma unroll
            for (int j = 0; j < 4; ++j) { const int c = 256 * j + 4 * lane;
                lng[j] = *(const f32x4*)(ln_b_g + c); lnb[j] = *(const f32x4*)(ln_b_b + c); hnb[j] = *(const f32x4*)(hn_b_g + c); hna[j] = *(const f32x4*)(hn_a_g + c);
                cw0[j] = *(const f32x4*)(conv_a_w + c); cw1[j] = *(const f32x4*)(conv_a_w + DA + c); cw2[j] = *(const f32x4*)(conv_a_w + 2 * DA + c); }
#pragma unroll 2
            for (int ii = 0; ii < CT / 8; ++ii) {
                const int i = (CT / 8) * wave + ii, t = t0 + i, tp = tpos + i;
                u32x2 pu0[4], pu1[4], pu2[4], pbb[4];
#pragma unroll
                for (int j = 0; j < 4; ++j) { const int c = 256 * j + 4 * lane;
                    pu0[j] = *(const u32x2*)(Ub + (size_t)t * DA + c); pbb[j] = *(const u32x2*)(BAb + (size_t)t * DA + c);
                    pu1[j] = (u32x2){0u, 0u}; pu2[j] = (u32x2){0u, 0u};
                    if (tp >= 1) pu1[j] = *(const u32x2*)(Ub + (size_t)(t - 1) * DA + c);
                    if (tp >= 2) pu2[j] = *(const u32x2*)(Ub + (size_t)(t - 2) * DA + c); }
                f32x4 z[4]; float s = 0.f;
#pragma unroll
                for (int j = 0; j < 4; ++j) { const u32x2 zq = *(const LAS u32x2*)(zl + i * DA + 256 * j + 4 * lane); z[j] = (f32x4){bflo(zq.x), bfhi(zq.x), bflo(zq.y), bfhi(zq.y)}; s += (z[j][0] + z[j][1]) + (z[j][2] + z[j][3]); }
                const float mean = wave_sum(s) * (1.0f / DA); float q = 0.f;
#pragma unroll
                for (int j = 0; j < 4; ++j) { z[j] = z[j] - mean; q += (z[j][0] * z[j][0] + z[j][1] * z[j][1]) + (z[j][2] * z[j][2] + z[j][3] * z[j][3]); }
                const float rstd = rsq(wave_sum(q) * (1.0f / DA) + EPS);
                unsigned char* yrow = (unsigned char*)Hb + (size_t)t * D;
#pragma unroll
                for (int j = 0; j < 4; ++j) {
                    f32x4 v = z[j] * rstd * lng[j] + lnb[j]; float ss = 0.f;
#pragma unroll
                    for (int e = 0; e < 4; ++e) { v[e] = v[e] * fast_sigmoid(v[e]); ss += v[e] * v[e]; }
                    ss = row_sum16(ss);
                    const float r = rsq(ss * (1.0f / 64.0f) + EPS);
                    const f32x4 o = v * (r * SC_YM) * hnb[j];
                    *(unsigned*)(yrow + DA + 256 * j + 4 * lane) = pk4_fp8(o[0], o[1], o[2], o[3]);
                }
#pragma unroll
                for (int j = 0; j < 4; ++j) { const int c = 256 * j + 4 * lane;
                    const u32x2 u0 = pu0[j], u1 = pu1[j], u2 = pu2[j], bb = pbb[j];
                    f32x4 U0 = (f32x4){bflo(u0.x), bfhi(u0.x), bflo(u0.y), bfhi(u0.y)}, U1 = (f32x4){bflo(u1.x), bfhi(u1.x), bflo(u1.y), bfhi(u1.y)}, U2 = (f32x4){bflo(u2.x), bfhi(u2.x), bflo(u2.y), bfhi(u2.y)};
                    const f32x4 Bq = (f32x4){bflo(bb.x), bfhi(bb.x), bflo(bb.y), bfhi(bb.y)};
                    const f32x4 ya = Bq * (cw0[j] * U2 + cw1[j] * U1 + cw2[j] * U0);
                    float ss = (ya[0] * ya[0] + ya[1] * ya[1]) + (ya[2] * ya[2] + ya[3] * ya[3]);
                    ss = row_sum16(ss);
                    const float r = rsq(ss * (1.0f / 64.0f) + EPS);
                    const f32x4 o = ya * (r * SC_YM) * hna[j];
                    *(unsigned*)(yrow + c) = pk4_fp8(o[0], o[1], o[2], o[3]); }
            }
        }
        __syncthreads();
    }
#undef P3_LOAD_TILE
#undef P3_STORE_TILE
#undef P3_LOAD_W
#undef P3_CONV
    SEAM(3);

    if (IN(4)) {
        KArgsP ap = kargs(); unsigned char* ws = ap->ws;
        const float* x = ap->in[0];
        WSP(float, mod, WS_MOD); WSP(float, ssq, WS_SSQ); WSP(bf16_t, WoutT, WS_WOUTT); WSP(bf16_t, Hb, WS_H); WSP(bf16_t, X2, WS_X2);
        pg8::DenseOrderG S; S.init(T, D, D, G, bx, WoutT);
        pg8::EpiOut E{x, mod, X2, ssq};
        pg8::gemm_phase<true, pg8::EpiOut, pg8::DenseOrderG>(lds, Hb, (unsigned)T * D, WoutT, (unsigned)D * D, D, S, E);
    }
    SEAM(4);

    if (IN(5)) {
        KArgsP ap = kargs(); unsigned char* ws = ap->ws;
        const float* norm_ffn_g = ap->in[14]; const float* router_bias = ap->in[16]; WSP(bf16_t, X2, WS_X2);
        WSP(float, mod, WS_MOD); WSP(float, ssq, WS_SSQ); WSP(int, tok_e, WS_TOKE); WSP(int, tok_r, WS_TOKR); WSP(float, tok_w, WS_TOKW); WSP(int, inv_tok, WS_INVT);
        WSP(bf16_t, WrThi, WS_WRT); bf16_t* WrTlo = WrThi + (size_t)NE * D; WSP(unsigned char, H2, WS_H2);
        unsigned* gcount = (unsigned*)(ws + WS_CTL) + CW_GCOUNT;
        LAS float* gsc = (LAS float*)lds; LAS float* shv = gsc + D;
        LAS unsigned char* slab = lds + 16384;
        LAS float* Sc = (LAS float*)(lds + 16384);
        LAS float* Mk = Sc + 128 * 65;
        LAS float* rbias = (LAS float*)(lds + 16384 + 65536 + 4096);
        LAS int* lcnt = (LAS int*)(rbias + 64); LAS int* lbase = lcnt + 64;
        for (int ch = bx; ch < T / 128; ch += G) {
            const int b = ch >> 4; const float* mb = mod + (size_t)b * (6 * D);
            __syncthreads();
            for (int k = tid; k < D; k += NTHR) { gsc[k] = norm_ffn_g[k] * (1.0f + mb[4 * D + k]); shv[k] = mb[3 * D + k]; }
            if (tid < NE) { rbias[tid] = router_bias[tid]; lcnt[tid] = 0; }
            __syncthreads();
            {
                const int r = lane & 15, q = lane >> 4, t = ch * 128 + wave * 16 + r;
                float s = 0.f;
#pragma unroll
                for (int p = 0; p < 8; ++p) s += ssq[(size_t)(q * 8 + p) * T + t];
                s += __shfl_xor(s, 16); s += __shfl_xor(s, 32);
                const float rstd = rsq(s * (1.0f / D) + EPS);
                f32x4 acc[4];
#pragma unroll
                for (int n = 0; n < 4; ++n) acc[n] = (f32x4){0.f, 0.f, 0.f, 0.f};
                const bf16_t* xrow = X2 + (size_t)t * D + 8 * q;
                unsigned char* hrow = H2 + (size_t)t * D + 8 * q;
                u32x4 xq[4];
#pragma unroll
                for (int s = 0; s < 4; ++s) xq[s] = *(const u32x4*)(xrow + 32 * s);
                unsigned sdst[4]; const bf16_t* ssrc[4];
#pragma unroll
                for (int j = 0; j < 4; ++j) { const int p = tid + 512 * j, hl = p >> 10, e = (p >> 4) & 63, kc = p & 15; const int ob = (e & 15) * 64 + (kc & 3) * 16;
                    sdst[j] = (unsigned)(((hl * 4 + (kc >> 2)) * 4 + (e >> 4)) * 1024 + (ob ^ (((ob >> 9) & 1) << 5))); ssrc[j] = (hl ? WrTlo : WrThi) + (size_t)e * D + 8 * kc; }
                const int fo = r * 64 + q * 16, foff = fo ^ (((fo >> 9) & 1) << 5);
                u32x4 sreg[4];
#pragma unroll
                for (int j = 0; j < 4; ++j) sreg[j] = *(const u32x4*)(ssrc[j]);
#pragma unroll
                for (int j = 0; j < 4; ++j) *(LAS u32x4*)(slab + sdst[j]) = sreg[j];
                __syncthreads();
#pragma unroll 1
                for (int k0 = 0; k0 < D; k0 += 128) {
                    const int it = k0 >> 7; LAS unsigned char* sb = slab + (it & 1) * 32768;
                    const int kn = (k0 + 128 < D) ? k0 + 128 : k0;
#pragma unroll
                    for (int j = 0; j < 4; ++j) sreg[j] = *(const u32x4*)(ssrc[j] + kn);
#pragma unroll
                    for (int s = 0; s < 4; ++s) {
                        const int kk = k0 + 32 * s;
                        const f32x4 ga = *(const LAS f32x4*)(gsc + kk + 8 * q), gb = *(const LAS f32x4*)(gsc + kk + 8 * q + 4);
                        const f32x4 sa = *(const LAS f32x4*)(shv + kk + 8 * q), sb4 = *(const LAS f32x4*)(shv + kk + 8 * q + 4);
                        const f32x4 xa4 = (f32x4){bflo(xq[s].x), bfhi(xq[s].x), bflo(xq[s].y), bfhi(xq[s].y)}, xb4 = (f32x4){bflo(xq[s].z), bfhi(xq[s].z), bflo(xq[s].w), bfhi(xq[s].w)};
                        const f32x4 ha = xa4 * rstd * ga + sa, hb = xb4 * rstd * gb + sb4;
                        const int kx = (kk + 128 < D) ? kk + 128 : kk;
                        xq[s] = *(const u32x4*)(xrow + kx);
                        u32x4 ph, pl;
                        ph.x = pk2(ha[0], ha[1]); ph.y = pk2(ha[2], ha[3]); ph.z = pk2(hb[0], hb[1]); ph.w = pk2(hb[2], hb[3]);
                        pl.x = pk2(ha[0] - bflo(ph.x), ha[1] - bfhi(ph.x)); pl.y = pk2(ha[2] - bflo(ph.y), ha[3] - bfhi(ph.y));
                        pl.z = pk2(hb[0] - bflo(ph.z), hb[1] - bfhi(ph.z)); pl.w = pk2(hb[2] - bflo(ph.w), hb[3] - bfhi(ph.w));
                        { u32x2 h8; h8.x = pk4_fp8(ha[0] * SC_H2, ha[1] * SC_H2, ha[2] * SC_H2, ha[3] * SC_H2); h8.y = pk4_fp8(hb[0] * SC_H2, hb[1] * SC_H2, hb[2] * SC_H2, hb[3] * SC_H2); *(u32x2*)(hrow + kk) = h8; }
                        const bf16x8 Ah = __builtin_bit_cast(bf16x8, ph), Al = __builtin_bit_cast(bf16x8, pl);
#pragma unroll
                        for (int n = 0; n < 4; ++n) {
                            const bf16x8 Bh = *(const LAS bf16x8*)(sb + ((0 * 4 + s) * 4 + n) * 1024 + foff), Bl = *(const LAS bf16x8*)(sb + ((1 * 4 + s) * 4 + n) * 1024 + foff);
                            acc[n] = __builtin_amdgcn_mfma_f32_16x16x32_bf16(Bh, Ah, acc[n], 0, 0, 0);
                            acc[n] = __builtin_amdgcn_mfma_f32_16x16x32_bf16(Bl, Ah, acc[n], 0, 0, 0);
                            acc[n] = __builtin_amdgcn_mfma_f32_16x16x32_bf16(Bh, Al, acc[n], 0, 0, 0);
                        }
                    }
#pragma unroll
                    for (int j = 0; j < 4; ++j) *(LAS u32x4*)(slab + ((it + 1) & 1) * 32768 + sdst[j]) = sreg[j];
                    __syncthreads();
                }
#pragma unroll
                for (int n = 0; n < 4; ++n)
#pragma unroll
                    for (int i = 0; i < 4; ++i) Sc[(wave * 16 + r) * 65 + 16 * n + 4 * q + i] = 1.0f / (1.0f + expf(-acc[n][i]));
            }
            __syncthreads();
            int idx[TOPK]; float wk[TOPK]; int lr[TOPK];
            const int tl = tid;
            if (tid < 128) {
                LAS float* srow = Sc + tl * 65; LAS float* mrow = Mk + tl * 65;
                float gs[8];
#pragma unroll
                for (int g = 0; g < 8; ++g) { float m1 = -INFINITY, m2 = -INFINITY;
#pragma unroll
                    for (int j = 0; j < 8; ++j) { const float v = srow[8 * g + j] + rbias[8 * g + j]; mrow[8 * g + j] = v; if (v > m1) { m2 = m1; m1 = v; } else if (v > m2) m2 = v; }
                    gs[g] = m1 + m2; }
                unsigned sel = 0u;
#pragma unroll
                for (int g = 0; g < 8; ++g) { int rank = 0;
#pragma unroll
                    for (int h = 0; h < 8; ++h) rank += (gs[h] > gs[g] || (gs[h] == gs[g] && h < g)) ? 1 : 0;
                    if (rank < 4) sel |= 1u << g; }
#pragma unroll
                for (int g = 0; g < 8; ++g) if (!((sel >> g) & 1u)) {
#pragma unroll
                    for (int j = 0; j < 8; ++j) mrow[8 * g + j] = -INFINITY; }
                float wsum = 0.f;
#pragma unroll
                for (int k = 0; k < TOPK; ++k) { float best = -INFINITY; int bi = 0;
#pragma unroll 8
                    for (int e = 0; e < NE; ++e) { const float v = mrow[e]; if (v > best) { best = v; bi = e; } }
                    mrow[bi] = -INFINITY; idx[k] = bi; wk[k] = srow[bi]; wsum += wk[k]; }
                const float inv = 2.5f / wsum;
#pragma unroll
                for (int k = 0; k < TOPK; ++k) { wk[k] *= inv; lr[k] = atomicAdd((int*)&lcnt[idx[k]], 1); }
            }
            __syncthreads();
            if (tid < NE) lbase[tid] = (int)atomicAdd(&gcount[tid], (unsigned)lcnt[tid]);
            __syncthreads();
            if (tid < 128) { const int t = ch * 128 + tl;
#pragma unroll
                for (int k = 0; k < TOPK; ++k) { const int e = idx[k], rank = lbase[e] + lr[k];
                    tok_e[t * 8 + k] = e; tok_r[t * 8 + k] = rank; tok_w[t * 8 + k] = wk[k]; inv_tok[e * T + rank] = t; }
                inv_tok[NE * T + t] = t; }
        }
        __syncthreads();
    }
    SEAM(5);

    if (IN(6)) {
        KArgsP ap = kargs(); unsigned char* ws = ap->ws;
        WSP(int, inv_tok, WS_INVT); WSP(unsigned char, W1T, WS_W1T); WSP(unsigned char, H2, WS_H2); WSP(unsigned char, ACT, WS_ACT);
        unsigned* gcount = (unsigned*)(ws + WS_CTL) + CW_GCOUNT;
        int NBr; build_tables(lds, gcount, NBr);
        pg8::MoeOrder<0, 4> S; S.blk_e = lds + TBL_BLKE; S.blkstart = (const LAS int*)(lds + TBL_BSTART); S.cnt = (const LAS int*)(lds + TBL_CNT);
        S.NB = NBr + 128; S.G = G; S.vcu = vcu; S.KB = D; S.Bt = W1T; S.estride = 1024u * D; S.boff0 = 0; S.inv_tok = inv_tok;
        pg8::EpiAct E{ACT};
        pg8::gemm_phase<true, pg8::EpiAct, pg8::MoeOrder<0, 4>>(lds, H2, (unsigned)T * D, W1T, 65u * 1024u * D, D, S, E);
    }
    SEAM(6);

    if (IN(7)) {
        KArgsP ap = kargs(); unsigned char* ws = ap->ws;
        WSP(int, inv_tok, WS_INVT); WSP(unsigned char, W2T, WS_W2T); WSP(unsigned char, ACT, WS_ACT); WSP(unsigned char, YR, WS_Y);
        unsigned* gcount = (unsigned*)(ws + WS_CTL) + CW_GCOUNT;
        int NBr; build_tables(lds, gcount, NBr);
        pg8::MoeOrder<1, 8> S; S.blk_e = lds + TBL_BLKE; S.blkstart = (const LAS int*)(lds + TBL_BSTART); S.cnt = (const LAS int*)(lds + TBL_CNT);
        S.NB = NBr + 128; S.G = G; S.vcu = vcu; S.KB = FE; S.Bt = W2T; S.estride = (unsigned)D * FE; S.boff0 = 0; S.inv_tok = inv_tok;
        pg8::EpiY8 E{YR};
        pg8::gemm_phase<true, pg8::EpiY8, pg8::MoeOrder<1, 8>>(lds, ACT, (unsigned)MAXBLK * 256 * FE, W2T, 65u * D * FE, FE, S, E);
    }
    SEAM(7);

    if (IN(8)) {
        KArgsP ap = kargs(); unsigned char* ws = ap->ws;
        const float* norm_final_g = ap->in[23]; float* out = ap->out;
        WSP(float, mod, WS_MOD); WSP(int, tok_e, WS_TOKE); WSP(int, tok_r, WS_TOKR); WSP(float, tok_w, WS_TOKW); WSP(unsigned char, YR, WS_Y); WSP(bf16_t, X2, WS_X2);
        unsigned* gcount = (unsigned*)(ws + WS_CTL) + CW_GCOUNT;
        int NBr; build_tables(lds, gcount, NBr);
        const LAS int* blkstart = (const LAS int*)(lds + TBL_BSTART);
        const int tstride = G * NWAVES;
        for (int t0 = vcu * NWAVES + wave; t0 < T; t0 += 2 * tstride) {
            int tt[2]; tt[0] = t0; tt[1] = (t0 + tstride < T) ? t0 + tstride : t0;
            f32x4 a[2][4][2];
#pragma unroll
            for (int u = 0; u < 2; ++u)
#pragma unroll
                for (int j = 0; j < 4; ++j) { a[u][j][0] = (f32x4){0.f, 0.f, 0.f, 0.f}; a[u][j][1] = (f32x4){0.f, 0.f, 0.f, 0.f}; }
#pragma unroll 3
            for (int k = 0; k < TOPK + 1; ++k) {
#pragma unroll
                for (int u = 0; u < 2; ++u) { const int t = tt[u];
                    int row; float w; constexpr float ys = 1.0f / SC_Y;
                    if (k < TOPK) { const int e = tok_e[t * 8 + k]; row = 256 * blkstart[e] + tok_r[t * 8 + k]; w = tok_w[t * 8 + k] * ys; } else { row = 256 * NBr + t; w = ys; }
                    const unsigned char* yr = YR + (size_t)row * D + 8 * lane;
#pragma unroll
                    for (int j = 0; j < 4; ++j) { const u32x2 y2 = *(const u32x2*)(yr + 512 * j);
                        const f32x2 p0 = __builtin_amdgcn_cvt_pk_f32_fp8((int)y2.x, false), p1 = __builtin_amdgcn_cvt_pk_f32_fp8((int)y2.x, true);
                        const f32x2 p2 = __builtin_amdgcn_cvt_pk_f32_fp8((int)y2.y, false), p3 = __builtin_amdgcn_cvt_pk_f32_fp8((int)y2.y, true);
                        a[u][j][0] = a[u][j][0] + w * (f32x4){p0.x, p0.y, p1.x, p1.y}; a[u][j][1] = a[u][j][1] + w * (f32x4){p2.x, p2.y, p3.x, p3.y}; } }
            }
#pragma unroll
            for (int u = 0; u < 2; ++u) { const int t = tt[u]; const int b = t >> 11; const float* gf = mod + (size_t)b * (6 * D) + 5 * D;
                float* orow = out + (size_t)t * D; const bf16_t* xrow = X2 + (size_t)t * D;
                float ss = 0.f;
#pragma unroll
                for (int j = 0; j < 4; ++j) { const u32x4 xq = *(const u32x4*)(xrow + 512 * j + 8 * lane);
#pragma unroll
                    for (int h = 0; h < 2; ++h) { const int c = 512 * j + 8 * lane + 4 * h; const unsigned q0 = h ? xq.z : xq.x, q1 = h ? xq.w : xq.y;
                        const f32x4 xv = (f32x4){bflo(q0), bfhi(q0), bflo(q1), bfhi(q1)}, g4 = *(const f32x4*)(gf + c);
                        a[u][j][h] = xv + g4 * a[u][j][h]; ss += (a[u][j][h][0] * a[u][j][h][0] + a[u][j][h][1] * a[u][j][h][1]) + (a[u][j][h][2] * a[u][j][h][2] + a[u][j][h][3] * a[u][j][h][3]); } }
                const float rstd = rsq(wave_sum(ss) * (1.0f / D) + EPS);
#pragma unroll
                for (int j = 0; j < 4; ++j)
#pragma unroll
                    for (int h = 0; h < 2; ++h) { const int c = 512 * j + 8 * lane + 4 * h; const f32x4 g0 = *(const f32x4*)(norm_final_g + c); *(f32x4*)(orow + c) = a[u][j][h] * rstd * g0; }
            }
        }
    }
#undef IN
#undef SEAM
}

extern "C" void kernel_launch(void* const* d_in, const int* in_sizes, int n_in, void* d_out, int out_size, void* d_ws, size_t ws_size, hipStream_t stream) {
    static int grid = 0;
    if (grid == 0) {
        if (n_in != 24 || out_size != T * D || ws_size < WS_END) { fprintf(stderr, "kernel_launch: unexpected problem (n_in %d, out %d, ws %zu)\n", n_in, out_size, ws_size); grid = -1; return; }
        int dev = 0, cus = 0, per_cu = 0;
        if (hipGetDevice(&dev) != hipSuccess || hipDeviceGetAttribute(&cus, hipDeviceAttributeMultiprocessorCount, dev) != hipSuccess) { grid = -1; return; }
        if (hipFuncSetAttribute((const void*)fwd_kernel, hipFuncAttributeMaxDynamicSharedMemorySize, LDS_BYTES) != hipSuccess) { fprintf(stderr, "kernel_launch: hipFuncSetAttribute failed\n"); grid = -1; return; }
        if (hipOccupancyMaxActiveBlocksPerMultiprocessor(&per_cu, (const void*)fwd_kernel, NTHR, LDS_BYTES) != hipSuccess || per_cu < 1) { fprintf(stderr, "kernel_launch: occupancy query says %d\n", per_cu); }
        (void)hipGetLastError();
        grid = cus;
    }
    if (grid < 0) return;
    (void)hipMemsetAsync((char*)d_ws + WS_CTL, 0, CTL_ZERO_BYTES, stream);
    Args a{};
    for (int i = 0; i < 24; ++i) a.in[i] = (const float*)d_in[i];
    a.out = (float*)d_out; a.ws = (unsigned char*)d_ws;
    constexpr int NPH = 9;
    if (MK_N_LAUNCHES == 1) {
        a.ph_lo = 0; a.ph_hi = NPH;
        hipLaunchKernelGGL(fwd_kernel, dim3(grid), dim3(NTHR), LDS_BYTES, stream, a);
    } else {
        for (int p = 0; p < NPH; ++p) { const int reps = ((REPEAT_MASK >> p) & 1) ? 2 : 1;
            for (int r = 0; r < reps; ++r) { if (p == 5 && r > 0) (void)hipMemsetAsync((char*)d_ws + WS_CTL + CW_GCOUNT * 4, 0, 256, stream);
                a.ph_lo = p; a.ph_hi = p + 1; hipLaunchKernelGGL(fwd_kernel, dim3(grid), dim3(NTHR), LDS_BYTES, stream, a); } }
    }
}
```

```cpp
#include <hip/hip_runtime.h>
#include <cstdio>
#include <cstdint>

#ifndef MK_N_LAUNCHES
#define MK_N_LAUNCHES 1
#endif
#ifndef REPEAT_MASK
#define REPEAT_MASK 0
#endif

#define GAS __attribute__((address_space(1)))
#define LAS __attribute__((address_space(3)))
typedef unsigned short bf16_t;
typedef short bf16x8 __attribute__((ext_vector_type(8)));
typedef float f32x4 __attribute__((ext_vector_type(4)));
typedef float f32x2 __attribute__((ext_vector_type(2)));
typedef unsigned u32x4 __attribute__((ext_vector_type(4)));
typedef unsigned u32x2 __attribute__((ext_vector_type(2)));

constexpr int T = 32768, D = 2048, NB_ = 16, SEQ = 2048, NE = 64, FE = 512, NPROJ = 5120, TOPK = 8;
constexpr int DA = 1024;
constexpr float EPS = 1e-6f;
constexpr int NWAVES = 8, NTHR = 512;
constexpr int MAXBLK = 1215;

constexpr size_t MiB = 1u << 20;
constexpr size_t WS_CTL = 0, CTL_ZERO_BYTES = 1 * MiB;
constexpr size_t WS_MOD = 1 * MiB;
constexpr size_t WS_SSQ = 2 * MiB;
constexpr size_t WS_TOKE = 6 * MiB;
constexpr size_t WS_TOKR = 7 * MiB;
constexpr size_t WS_TOKW = 8 * MiB;
constexpr size_t WS_INVT = 9 * MiB;
constexpr size_t WS_WRT = 18 * MiB;
constexpr size_t WS_W2T = 32 * MiB;
constexpr size_t WS_ACT = 162 * MiB;
constexpr size_t WS_X2 = 320 * MiB;
constexpr size_t WS_UBG = 162 * MiB;
constexpr size_t WS_Y = 466 * MiB;
constexpr size_t WS_W1T = 466 * MiB;
constexpr size_t WS_WINT = 726 * MiB;
constexpr size_t WS_WOUTT = 746 * MiB;
constexpr size_t WS_H2 = 754 * MiB;
constexpr size_t WS_H = 882 * MiB;
constexpr size_t WS_END = 1074 * MiB;
static_assert(WS_Y + (size_t)MAXBLK * 256 * 2048 <= WS_END, "ws map");
static_assert(WS_ACT + (size_t)MAXBLK * 256 * 512 * 2 <= WS_Y, "ws map");
constexpr int CW_BAR = 4096;
constexpr int CW_GCOUNT = 8192;

constexpr int RING_BYTES = 131072;
constexpr int TBL_OFF = RING_BYTES;
constexpr int TBL_BLKE = TBL_OFF, TBL_BSTART = TBL_OFF + 1280, TBL_CNT = TBL_BSTART + 66 * 4 + 8;
constexpr int MISC_OFF = RING_BYTES + 4096;
constexpr int GATH_OFF = RING_BYTES + 4096 + 256;
constexpr int LDS_BYTES = 147456;
static_assert(GATH_OFF + 8192 <= LDS_BYTES, "LDS map");
static_assert(TBL_CNT + 64 * 4 <= MISC_OFF && MISC_OFF + 128 <= LDS_BYTES, "LDS map");

__device__ __forceinline__ unsigned f2bf(float f) { unsigned u = __builtin_bit_cast(unsigned, f); return (u + 0x7fffu + ((u >> 16) & 1u)) >> 16; }
__device__ __forceinline__ float bflo(unsigned w) { return __uint_as_float(w << 16); }
__device__ __forceinline__ float bfhi(unsigned w) { return __uint_as_float(w & 0xffff0000u); }
template <int CTRL> __device__ __forceinline__ float dpp_mov(float v) { return __builtin_bit_cast(float, __builtin_amdgcn_update_dpp(0, __builtin_bit_cast(int, v), CTRL, 0xF, 0xF, true)); }
__device__ __forceinline__ float row_sum16(float v) {
    v += dpp_mov<0xB1>(v); v += dpp_mov<0x4E>(v); v += dpp_mov<0x141>(v); v += dpp_mov<0x140>(v); return v; }
__device__ __forceinline__ float rdlane(float v, int l) { return __builtin_bit_cast(float, __builtin_amdgcn_readlane(__builtin_bit_cast(int, v), l)); }
__device__ __forceinline__ float wave_sum(float v) { v = row_sum16(v); return (rdlane(v, 0) + rdlane(v, 16)) + (rdlane(v, 32) + rdlane(v, 48)); }
__device__ __forceinline__ float fast_sigmoid(float x) { return __builtin_amdgcn_rcpf(1.0f + __builtin_amdgcn_exp2f(-1.44269504089f * x)); }
constexpr float SC_H = 16.0f, SC_WI = 512.0f;
constexpr float SC_YM = 16.0f, SC_WO = 512.0f;
constexpr float SC_H2 = 16.0f, SC_W1 = 512.0f, SC_ACT = 8.0f, SC_W2 = 4.0f, SC_Y = SC_ACT * SC_W2;
__device__ __forceinline__ float clamp448(float v) { return __builtin_amdgcn_fmed3f(v, -448.0f, 448.0f); }
__device__ __forceinline__ unsigned pk4_fp8(float a, float b, float c, float d) {
    int r = __builtin_amdgcn_cvt_pk_fp8_f32(clamp448(a), clamp448(b), 0, false);
    r = __builtin_amdgcn_cvt_pk_fp8_f32(clamp448(c), clamp448(d), r, true);
    return (unsigned)r;
}
typedef int i32x8 __attribute__((ext_vector_type(8)));
typedef int i32x4v __attribute__((ext_vector_type(4)));
__device__ __forceinline__ unsigned cvt_pk_bf16(float lo, float hi) { unsigned r; asm volatile("v_cvt_pk_bf16_f32 %0, %1, %2" : "=v"(r) : "v"(lo), "v"(hi)); return r; }
__device__ __forceinline__ unsigned pk2(float lo, float hi) { unsigned r; asm("v_cvt_pk_bf16_f32 %0, %1, %2" : "=v"(r) : "v"(lo), "v"(hi)); return r; }
__device__ __forceinline__ float rsq(float x) { return __builtin_amdgcn_rsqf(x); }

#define XB_TMO      128
#define XB_XCNT(j)  (256  + 64 * (j))
#define XB_XSUB(j)  (1280 + 64 * (j))
#define XB_XGEN(j)  (2304 + 64 * (j))
#define XB_TOP      3328
#define XB_TOPGEN   3392
#define XCD_BAR_WORDS 3456
#define XB_SPIN_CAP (1u << 18)
__device__ __forceinline__ unsigned xb_ld(unsigned* p)              { return __hip_atomic_load(p, __ATOMIC_RELAXED, __HIP_MEMORY_SCOPE_AGENT); }
__device__ __forceinline__ unsigned xb_add(unsigned* p, unsigned v) { return __hip_atomic_fetch_add(p, v, __ATOMIC_RELAXED, __HIP_MEMORY_SCOPE_AGENT); }
__device__ __forceinline__ unsigned xb_xcc_id() { return (unsigned)__builtin_amdgcn_s_getreg((3 << 11) | 20) & 0xFu; }
#define XB_SPIN(cond, bar) do { unsigned _sp = 0; while (cond) { __builtin_amdgcn_s_sleep(1); \
    if ((++_sp & 255u) == 0u) { if (xb_ld(&(bar)[XB_TMO])) break; if (_sp > XB_SPIN_CAP) { atomicAdd(&(bar)[XB_TMO], 1u); break; } } } } while (0)
struct XcdBarrier { unsigned* bar; unsigned x; volatile LAS unsigned* st; };
__device__ __forceinline__ XcdBarrier xcd_barrier_post(unsigned* bar, volatile LAS unsigned* st) {
    XcdBarrier b; b.bar = bar; b.x = xb_xcc_id(); b.st = st;
    if (threadIdx.x == 0) (void)xb_add(&bar[XB_XCNT(b.x)], 1u);
    return b;
}
__device__ __forceinline__ void xcd_barrier_complete(unsigned* bar, unsigned x, unsigned& nloc, unsigned& nx) {
    const unsigned G = gridDim.x * gridDim.y * gridDim.z;
    unsigned sum, cnt, mine, sp = 0u;
    for (;;) {
        sum = 0u; cnt = 0u; mine = 0u;
#pragma unroll
        for (unsigned j = 0; j < 16; ++j) { const unsigned c = xb_ld(&bar[XB_XCNT(j)]); sum += c; cnt += (c > 0u) ? 1u : 0u; mine = (j == x) ? c : mine; }
        if (sum == G) break;
        __builtin_amdgcn_s_sleep(1);
        if ((++sp & 255u) == 0u) { if (xb_ld(&bar[XB_TMO])) break; if (sp > XB_SPIN_CAP) { atomicAdd(&bar[XB_TMO], 1u); break; } }
    }
    nloc = mine > 0u ? mine : 1u; nx = cnt > 0u ? cnt : 1u;
}
__device__ __forceinline__ void xcd_barrier(const XcdBarrier& b) {
    asm volatile("s_waitcnt vmcnt(0)" ::: "memory");
    __syncthreads();
    if (threadIdx.x == 0) {
        unsigned* bar = b.bar;
        __builtin_amdgcn_s_waitcnt(0);
        unsigned nloc = b.st[0], nx = b.st[1];
        if (nloc == 0u) { xcd_barrier_complete(bar, b.x, nloc, nx); b.st[0] = nloc; b.st[1] = nx; }
        const unsigned old = xb_add(&bar[XB_XSUB(b.x)], 1u);
        const unsigned gen = old / nloc;
        if (old + 1u == (gen + 1u) * nloc) {
            __builtin_amdgcn_fence(__ATOMIC_RELEASE, "agent");
            asm volatile("s_waitcnt vmcnt(0)" ::: "memory");
            const unsigned og = xb_add(&bar[XB_TOP], 1u);
            const unsigned tg = og / nx;
            if (og + 1u == (tg + 1u) * nx) xb_add(&bar[XB_TOPGEN], 1u);
            else XB_SPIN(xb_ld(&bar[XB_TOPGEN]) == tg, bar);
            __builtin_amdgcn_fence(__ATOMIC_ACQUIRE, "agent");
            xb_add(&bar[XB_XGEN(b.x)], 1u);
            asm volatile("s_waitcnt vmcnt(0)" ::: "memory");
        } else {
            XB_SPIN(xb_ld(&bar[XB_XGEN(b.x)]) == gen, bar);
            __builtin_amdgcn_fence(__ATOMIC_ACQUIRE, "agent");
            asm volatile("s_waitcnt vmcnt(0)" ::: "memory");
        }
    }
    __syncthreads();
}

namespace pg8 {
constexpr int BM = 256, BK = 64, HALF = 128, HTB = HALF * BK * 2, STAGE_BYTES = 8 * HTB;
__host__ __device__ __forceinline__ int lds_byte(int r, int c) { const int st = (r >> 4) * 2 + (c >> 5), rr = r & 15, cc = c & 31, ob = rr * 64 + cc * 2; return st * 1024 + (ob ^ (((ob >> 9) & 1) << 5)); }
__host__ __device__ __forceinline__ void stage_rc(int b, int& R, int& C) { const int st = b / 1024, sb = b % 1024, swz = sb ^ (((sb >> 9) & 1) << 5); R = (st >> 1) * 16 + swz / 64; C = (st & 1) * 32 + (swz % 64) / 2; }
__host__ __device__ __forceinline__ int perm32(int rho) { const int n = rho >> 4, i = rho & 15; return 8 * (i >> 2) + 4 * n + (i & 3); }

struct Unit { int pm, pn, e; };

struct DenseOrder {
    static constexpr bool GATHER = false;
    int nM, nN, nwg, G, c, KB; const void* Bt;
    __device__ void init(int M, int N, int KB_, int G_, int c_, const void* Bt_) { nM = M / BM; nN = N / BM; nwg = nM * nN; G = G_; c = c_; KB = KB_; Bt = Bt_; }
    __device__ __forceinline__ bool next(int i, Unit& u) const {
        const long L = (long)i * G + c; if (L >= nwg) return false;
        int wgid = (int)L; { const int q = nwg / 8, r = nwg % 8, xcd = wgid % 8, off = wgid / 8; wgid = (xcd < r ? xcd * (q + 1) : r * (q + 1) + (xcd - r) * q) + off; }
        const int nig = 8 * nN, gid = wgid / nig, fm = gid * 8, gsz = (nM - fm) < 8 ? (nM - fm) : 8;
        u.pm = fm + ((wgid % nig) % gsz); u.pn = (wgid % nig) / gsz; u.e = 0; return true;
    }
    __device__ __forceinline__ unsigned b_off(const Unit& u) const { return (unsigned)u.pn * (256u * (unsigned)KB); }
    __device__ __forceinline__ unsigned a_unit_off(const Unit& u) const { return (unsigned)u.pm * (256u * (unsigned)KB); }
    __device__ __forceinline__ void prefetch_rows(const Unit&, LAS unsigned char*, int, int, int) const {}
    __device__ __forceinline__ void fetch_rows(const Unit&, LAS unsigned char*, int, int, int, int, unsigned (&)[2][2]) const {}
};
struct DenseOrderG : DenseOrder {
    static constexpr bool GATHER = true;
    __device__ __forceinline__ unsigned a_unit_off(const Unit&) const { return 0u; }
    __device__ __forceinline__ void fetch_rows(const Unit& u, LAS unsigned char*, int, int, int R0, int C0, unsigned (&v)[2][2]) const {
#pragma unroll
        for (int h = 0; h < 2; ++h)
#pragma unroll
            for (int i = 0; i < 2; ++i) v[h][i] = (unsigned)(u.pm * 256 + 128 * h + R0 + 64 * i) * (unsigned)KB + 2u * C0;
    }
};
template <int MODE, int NPN> struct MoeOrder {
    static constexpr bool GATHER = true;
    const LAS unsigned char* blk_e; const LAS int* blkstart; const LAS int* cnt;
    int NB, G, vcu, KB; const void* Bt; unsigned estride, boff0; const int* inv_tok;
    __device__ __forceinline__ bool next(int i, Unit& u) const {
        const int L = i * G + vcu, grp = L / (8 * NPN), w = L % (8 * NPN), rb = grp * 8 + (w & 7);
        if (rb >= NB) return false;
        u.pm = rb; u.pn = w >> 3; u.e = __builtin_amdgcn_readfirstlane((int)blk_e[rb]); return true;
    }
    __device__ __forceinline__ unsigned b_off(const Unit& u) const { return (unsigned)u.e * estride + boff0 + (unsigned)u.pn * (256u * (unsigned)KB); }
    __device__ __forceinline__ unsigned a_unit_off(const Unit& u) const { return 0u; }
    __device__ __forceinline__ void prefetch_rows(const Unit& u, LAS unsigned char* slots, int wid, int lane, int R0) const {
        if (MODE == 0) {
            const int lb = u.pm - __builtin_amdgcn_readfirstlane(blkstart[u.e]);
            const int n = (u.e < NE) ? __builtin_amdgcn_readfirstlane(cnt[u.e]) : T;
            const int* src = inv_tok + (size_t)u.e * T;
#pragma unroll
            for (int h = 0; h < 2; ++h)
#pragma unroll
                for (int i = 0; i < 2; ++i) { int rank = lb * 256 + 128 * h + R0 + 64 * i; rank = rank < n ? rank : n - 1;
                    __builtin_amdgcn_global_load_lds((const unsigned*)(src + rank), (LAS unsigned*)(slots + wid * 1024 + (h * 2 + i) * 256), 4, 0, 0); }
        }
    }
    __device__ __forceinline__ void fetch_rows(const Unit& u, LAS unsigned char* slots, int wid, int lane, int R0, int C0, unsigned (&v)[2][2]) const {
#pragma unroll
        for (int h = 0; h < 2; ++h)
#pragma unroll
            for (int i = 0; i < 2; ++i) {
                int row;
                if (MODE == 0) row = ((const LAS int*)(slots + wid * 1024 + (h * 2 + i) * 256))[lane]; else row = u.pm * 256 + 128 * h + R0 + 64 * i;
                v[h][i] = (unsigned)row * (unsigned)KB + 2u * C0; }
    }
};


struct EpiProj {
    static constexpr int BHALF_ROWS = 128;
    static __device__ __forceinline__ int brow(int R) { return (R & ~31) + perm32(R & 31); }
    bf16_t* U; bf16_t* BA; bf16_t* GLU;
    __device__ __forceinline__ void operator()(const f32x4 (&acc)[2][2][4][2], const Unit& u, int wr, int wc, int fr, int fq) const {
        const int row0 = u.pm * BM + wr * 64 + fr, pn = u.pn;
        if (pn >= 8 && pn < 12) {
            const int col0 = 256 * (pn - 8) + wc * 32 + 8 * fq;
#pragma unroll
            for (int ai = 0; ai < 2; ++ai)
#pragma unroll
                for (int m = 0; m < 4; ++m) { bf16_t* rowp = BA + (size_t)(row0 + ai * HALF + m * 16) * DA + col0;
#pragma unroll
                    for (int bj = 0; bj < 2; ++bj) { constexpr float sp = 1.0f / (SC_H * SC_WI); const f32x4 v0 = acc[ai][bj][m][0] * sp, v1 = acc[ai][bj][m][1] * sp;
                        u32x4 w; w.x = cvt_pk_bf16(v0[0], v0[1]); w.y = cvt_pk_bf16(v0[2], v0[3]); w.z = cvt_pk_bf16(v1[0], v1[1]); w.w = cvt_pk_bf16(v1[2], v1[3]);
                        *(u32x4*)(rowp + bj * HALF) = w; } }
        } else {
            const bool isu = pn < 8; bf16_t* base = isu ? U : GLU; const int col0 = 128 * (isu ? pn : pn - 12) + wc * 32 + 8 * fq;
#pragma unroll
            for (int ai = 0; ai < 2; ++ai)
#pragma unroll
                for (int m = 0; m < 4; ++m) { bf16_t* rowp = base + (size_t)(row0 + ai * HALF + m * 16) * DA + col0;
                    constexpr float sp = 1.0f / (SC_H * SC_WI);
                    f32x4 a0 = acc[ai][0][m][0] * sp, a1 = acc[ai][0][m][1] * sp; const f32x4 b0 = acc[ai][1][m][0] * sp, b1 = acc[ai][1][m][1] * sp;
                    if (isu) { a0 = a0 * b0; a1 = a1 * b1; }
                    else {
#pragma unroll
                        for (int j = 0; j < 4; ++j) { a0[j] = a0[j] * fast_sigmoid(b0[j]); a1[j] = a1[j] * fast_sigmoid(b1[j]); } }
                    u32x4 w; w.x = cvt_pk_bf16(a0[0], a0[1]); w.y = cvt_pk_bf16(a0[2], a0[3]); w.z = cvt_pk_bf16(a1[0], a1[1]); w.w = cvt_pk_bf16(a1[2], a1[3]);
                    *(u32x4*)rowp = w; }
        }
    }
};
struct EpiOut {
    static constexpr int BHALF_ROWS = 128;
    static __device__ __forceinline__ int brow(int R) { return (R & ~31) + perm32(R & 31); }
    const float* x; const float* mod; bf16_t* x2; float* ssq;
    __device__ __forceinline__ void operator()(const f32x4 (&acc)[2][2][4][2], const Unit& u, int wr, int wc, int fr, int fq) const {
        const int row0 = u.pm * BM + wr * 64 + fr, col0 = u.pn * BM + wc * 32 + 8 * fq;
        const float* gm = mod + (size_t)(u.pm >> 3) * (6 * D) + 2 * D;
        f32x4 gv[2][2];
#pragma unroll
        for (int bj = 0; bj < 2; ++bj)
#pragma unroll
            for (int n = 0; n < 2; ++n) gv[bj][n] = *(const f32x4*)(gm + col0 + bj * HALF + 4 * n);
#pragma unroll
        for (int ai = 0; ai < 2; ++ai)
#pragma unroll
          for (int mp = 0; mp < 2; ++mp) {
            f32x4 xv[2][2][2];
#pragma unroll
            for (int mm = 0; mm < 2; ++mm)
#pragma unroll
                for (int bj = 0; bj < 2; ++bj)
#pragma unroll
                    for (int n = 0; n < 2; ++n) xv[mm][bj][n] = *(const f32x4*)(x + (size_t)(row0 + ai * HALF + (2 * mp + mm) * 16) * D + col0 + bj * HALF + 4 * n);
            asm volatile("" ::: "memory");
#pragma unroll
            for (int mm = 0; mm < 2; ++mm) { const int m = 2 * mp + mm; const int row = row0 + ai * HALF + m * 16; const size_t off = (size_t)row * D + col0; float s = 0.f;
#pragma unroll
                for (int bj = 0; bj < 2; ++bj) { constexpr float so = 1.0f / (SC_YM * SC_WO); const f32x4 o0 = xv[mm][bj][0] + gv[bj][0] * (acc[ai][bj][m][0] * so), o1 = xv[mm][bj][1] + gv[bj][1] * (acc[ai][bj][m][1] * so);
                    u32x4 w; w.x = pk2(o0[0], o0[1]); w.y = pk2(o0[2], o0[3]); w.z = pk2(o1[0], o1[1]); w.w = pk2(o1[2], o1[3]);
                    *(u32x4*)(x2 + off + bj * HALF) = w;
                    const float r0 = bflo(w.x), r1 = bfhi(w.x), r2 = bflo(w.y), r3 = bfhi(w.y), r4 = bflo(w.z), r5 = bfhi(w.z), r6 = bflo(w.w), r7 = bfhi(w.w);
                    s += ((r0 * r0 + r1 * r1) + (r2 * r2 + r3 * r3)) + ((r4 * r4 + r5 * r5) + (r6 * r6 + r7 * r7)); }
                s += __shfl_xor(s, 16); s += __shfl_xor(s, 32);
                if (fq == 0) ssq[(size_t)(u.pn * 4 + wc) * T + row] = s; }
            asm volatile("" ::: "memory");
          }
    }
};
struct EpiAct {
    static constexpr int BHALF_ROWS = 128;
    static __device__ __forceinline__ int brow(int R) { return (R & ~31) + perm32(R & 31); }
    unsigned char* act;
    __device__ __forceinline__ void operator()(const f32x4 (&acc)[2][2][4][2], const Unit& u, int wr, int wc, int fr, int fq) const {
        const int row0 = u.pm * BM + wr * 64 + fr, col0 = 128 * u.pn + wc * 32 + 8 * fq;
#pragma unroll
        for (int ai = 0; ai < 2; ++ai)
#pragma unroll
            for (int m = 0; m < 4; ++m) { unsigned char* rowp = act + (size_t)(row0 + ai * HALF + m * 16) * FE + col0;
                constexpr float s1 = 1.0f / (SC_H2 * SC_W1), s2 = SC_ACT / (SC_H2 * SC_W1);
                f32x4 a0 = acc[ai][0][m][0] * s1, a1 = acc[ai][0][m][1] * s1; const f32x4 b0 = acc[ai][1][m][0] * s2, b1 = acc[ai][1][m][1] * s2;
#pragma unroll
                for (int j = 0; j < 4; ++j) { a0[j] = a0[j] * fast_sigmoid(a0[j]) * b0[j]; a1[j] = a1[j] * fast_sigmoid(a1[j]) * b1[j]; }
                u32x2 w; w.x = pk4_fp8(a0[0], a0[1], a0[2], a0[3]); w.y = pk4_fp8(a1[0], a1[1], a1[2], a1[3]);
                *(u32x2*)rowp = w; }
    }
};
struct EpiY8 {
    static constexpr int BHALF_ROWS = 8;
    static __device__ __forceinline__ int brow(int R) { return 64 * (R >> 5) + 16 * ((R & 15) >> 2) + 4 * ((R >> 4) & 1) + (R & 3); }
    unsigned char* Y;
    __device__ __forceinline__ void operator()(const f32x4 (&acc)[2][2][4][2], const Unit& u, int wr, int wc, int fr, int fq) const {
        const int row0 = u.pm * BM + wr * 64 + fr, col0 = u.pn * BM + 64 * wc + 16 * fq;
        static_assert(SC_Y == SC_ACT * SC_W2, "y rows are stored unscaled");
#pragma unroll
        for (int ai = 0; ai < 2; ++ai)
#pragma unroll
            for (int m = 0; m < 4; ++m) { unsigned char* rowp = Y + (size_t)(row0 + ai * HALF + m * 16) * D + col0;
                const f32x4 v0 = acc[ai][0][m][0], v1 = acc[ai][0][m][1], v2 = acc[ai][1][m][0], v3 = acc[ai][1][m][1];
                u32x4 w; w.x = pk4_fp8(v0[0], v0[1], v0[2], v0[3]); w.y = pk4_fp8(v1[0], v1[1], v1[2], v1[3]); w.z = pk4_fp8(v2[0], v2[1], v2[2], v2[3]); w.w = pk4_fp8(v3[0], v3[1], v3[2], v3[3]);
                __builtin_nontemporal_store(w, (u32x4*)rowp); }
    }
};

template <bool FP8, class Epi, class Sched>
__device__ __forceinline__ void gemm_phase(LAS unsigned char* lds, const void* A, unsigned abytes, const void* Bt, unsigned bbytes, const int KB_, const Sched& S, const Epi& E) {
    int KB = KB_; asm volatile("" : "+s"(KB));
    const int tid = threadIdx.x, wid = __builtin_amdgcn_readfirstlane(tid >> 6), lane = tid & 63, wr = wid >> 2, wc = wid & 3, fr = lane & 15, fq = lane >> 4;
    const int nt = KB / 128;
    int R0, C0; stage_rc(tid * 16, R0, C0);
    unsigned voffB[2], vd[2];
#pragma unroll
    for (int i = 0; i < 2; ++i) { const int R = R0 + 64 * i; const int Rb = Epi::brow(R); voffB[i] = (unsigned)Rb * (unsigned)KB + 2u * C0; vd[i] = (unsigned)R * (unsigned)KB + 2u * C0; }
    constexpr bool GA = Sched::GATHER;
    LAS unsigned char* slots = lds + GATH_OFF;
    const __amdgpu_buffer_rsrc_t rsA = __builtin_amdgcn_make_buffer_rsrc((void*)A, 0, (int)abytes, 0x00020000);
    const __amdgpu_buffer_rsrc_t rsB = __builtin_amdgcn_make_buffer_rsrc((void*)Bt, 0, (int)bbytes, 0x00020000);
    const unsigned kstep = 128u;
    const unsigned hstep = (unsigned)HALF * (unsigned)KB;
    const unsigned hstepB = (unsigned)Epi::BHALF_ROWS * (unsigned)KB;
    const unsigned ldsw = (unsigned)wid * 1024u;
    const int aoff = lds_byte(wr * 64 + fr, fq * 8), boff = lds_byte(wc * 32 + fr, fq * 8);
#define PG8_SA(b, h) (((b) * 2 + (h)) * HTB)
#define PG8_SB(b, h) ((4 + (b) * 2 + (h)) * HTB)
#define PG8_STAGE(bufoff, rs, soff, voff) do { _Pragma("unroll") for (int _i = 0; _i < 2; ++_i) \
        __builtin_amdgcn_raw_ptr_buffer_load_lds(rs, (LAS void*)(lds + (bufoff) + ldsw + _i * 8192), 16, (int)(voff)[_i], (int)(soff), 0, 0); } while (0)
#define PG8_STAGE_A(bufoff, so, h) do { if constexpr (GA) PG8_STAGE(bufoff, rsA, so, vc[h]); else PG8_STAGE(bufoff, rsA, (so) + (h) * hstep, vd); } while (0)
#define PG8_LDA(dst, b, h) do { _Pragma("unroll") for (int m = 0; m < 4; ++m) { \
        if constexpr (FP8) { const i32x4v _lo = *(const LAS i32x4v*)(lds + PG8_SA(b, h) + aoff + m * 2048), _hi = *(const LAS i32x4v*)(lds + PG8_SA(b, h) + aoff + m * 2048 + 1024); \
            dst##8[m] = __builtin_shufflevector(_lo, _hi, 0, 1, 2, 3, 4, 5, 6, 7); } \
        else { _Pragma("unroll") for (int k = 0; k < 2; ++k) dst[m][k] = *(const LAS bf16x8*)(lds + PG8_SA(b, h) + aoff + m * 2048 + k * 1024); } } } while (0)
#define PG8_LDB(dst, b, h) do { _Pragma("unroll") for (int n = 0; n < 2; ++n) { \
        if constexpr (FP8) { const i32x4v _lo = *(const LAS i32x4v*)(lds + PG8_SB(b, h) + boff + n * 2048), _hi = *(const LAS i32x4v*)(lds + PG8_SB(b, h) + boff + n * 2048 + 1024); \
            dst##8[n] = __builtin_shufflevector(_lo, _hi, 0, 1, 2, 3, 4, 5, 6, 7); } \
        else { _Pragma("unroll") for (int k = 0; k < 2; ++k) dst[n][k] = *(const LAS bf16x8*)(lds + PG8_SB(b, h) + boff + n * 2048 + k * 1024); } } } while (0)
#define PG8_MMA(ai, bj, At, Bt) do { __builtin_amdgcn_s_setprio(1); _Pragma("unroll") for (int m = 0; m < 4; ++m) _Pragma("unroll") for (int n = 0; n < 2; ++n) { \
        if constexpr (FP8) { acc[ai][bj][m][n] = __builtin_amdgcn_mfma_scale_f32_16x16x128_f8f6f4(Bt##8[n], At##8[m], acc[ai][bj][m][n], 0, 0, 0, 0x7F7F7F7F, 0, 0x7F7F7F7F); } \
        else { _Pragma("unroll") for (int k = 0; k < 2; ++k) acc[ai][bj][m][n] = __builtin_amdgcn_mfma_f32_16x16x32_bf16(Bt[n][k], At[m][k], acc[ai][bj][m][n], 0, 0, 0); } } \
        __builtin_amdgcn_s_setprio(0); } while (0)
#define PG8_WAIT_V(n) asm volatile("s_waitcnt vmcnt(" #n ")" ::: "memory")
#define PG8_WAIT_L(n) asm volatile("s_waitcnt lgkmcnt(" #n ")" ::: "memory")
#define PG8_BAR __builtin_amdgcn_s_barrier()
#define PG8_SCHED __builtin_amdgcn_sched_barrier(0)
    Unit cur, nxt; int ui = 0;
    if (!S.next(0, cur)) return;
    f32x4 acc[2][2][4][2];
#pragma unroll
    for (int a = 0; a < 2; ++a)
#pragma unroll
        for (int b = 0; b < 2; ++b)
#pragma unroll
            for (int m = 0; m < 4; ++m)
#pragma unroll
                for (int n = 0; n < 2; ++n) acc[a][b][m][n] = (f32x4){0.f, 0.f, 0.f, 0.f};
    bf16x8 At[4][2], B0[2][2], B1[2][2];
    i32x8 At8[4], B08[2], B18[2];
    unsigned cA = S.a_unit_off(cur), cB = S.b_off(cur);
    unsigned vc[2][2] = {{0u, 0u}, {0u, 0u}};
    if constexpr (GA) { S.prefetch_rows(cur, slots, wid, lane, R0); PG8_WAIT_V(0); S.fetch_rows(cur, slots, wid, lane, R0, C0, vc); PG8_WAIT_L(0); }
    PG8_STAGE(PG8_SB(0, 0), rsB, cB, voffB); PG8_STAGE(PG8_SB(0, 1), rsB, cB + hstepB, voffB); PG8_STAGE_A(PG8_SA(0, 0), cA, 0); PG8_STAGE_A(PG8_SA(0, 1), cA, 1);
    if (wr == 1) PG8_BAR;
    PG8_WAIT_V(2); PG8_BAR;
    PG8_STAGE(PG8_SB(1, 0), rsB, cB + kstep, voffB); PG8_STAGE_A(PG8_SA(1, 0), cA + kstep, 0); PG8_STAGE(PG8_SB(1, 1), rsB, cB + hstepB + kstep, voffB);
    PG8_WAIT_V(6); PG8_BAR;
    for (;;) {
        const bool has_next = S.next(ui + 1, nxt);
        unsigned nB = cB, nA = cA;
        if (has_next) { nB = S.b_off(nxt); nA = S.a_unit_off(nxt); if constexpr (GA) S.prefetch_rows(nxt, slots, wid, lane, R0); }
#pragma unroll 1
        for (int t = 0; t < nt; t += 2) {
            const bool last = (t == nt - 2);
            const unsigned a1 = cA + (unsigned)(t + 1) * kstep;
            const unsigned a2 = last ? nA : cA + (unsigned)(t + 2) * kstep, b2 = last ? nB : cB + (unsigned)(t + 2) * kstep;
            const unsigned a3 = a2 + kstep, b3 = b2 + kstep;
            PG8_LDB(B0, 0, 0); PG8_LDB(B1, 0, 1); PG8_SCHED; PG8_LDA(At, 0, 0); PG8_STAGE_A(PG8_SA(1, 1), a1, 1);
            if constexpr (GA) { if (last && has_next) S.fetch_rows(nxt, slots, wid, lane, R0, C0, vc); }
            PG8_WAIT_V(8); PG8_WAIT_L(0); PG8_BAR; PG8_MMA(0, 0, At, B0); PG8_MMA(0, 1, At, B1); PG8_BAR; PG8_SCHED;
            PG8_LDA(At, 0, 1); PG8_STAGE(PG8_SB(0, 0), rsB, b2, voffB); PG8_STAGE(PG8_SB(0, 1), rsB, b2 + hstepB, voffB); PG8_STAGE_A(PG8_SA(0, 0), a2, 0);
            PG8_WAIT_V(8); PG8_WAIT_L(0); PG8_BAR; PG8_MMA(1, 0, At, B0); PG8_MMA(1, 1, At, B1); PG8_BAR; PG8_SCHED;
            PG8_LDB(B0, 1, 0); PG8_LDB(B1, 1, 1); PG8_SCHED; PG8_LDA(At, 1, 0); PG8_STAGE_A(PG8_SA(0, 1), a2, 1);
            PG8_WAIT_V(8); PG8_WAIT_L(0); PG8_BAR; PG8_MMA(0, 0, At, B0); PG8_MMA(0, 1, At, B1); PG8_BAR; PG8_SCHED;
            PG8_LDA(At, 1, 1); PG8_STAGE(PG8_SB(1, 0), rsB, b3, voffB); PG8_STAGE(PG8_SB(1, 1), rsB, b3 + hstepB, voffB); PG8_STAGE_A(PG8_SA(1, 0), a3, 0);
            PG8_WAIT_V(8); PG8_WAIT_L(0); PG8_BAR; PG8_MMA(1, 0, At, B0); PG8_MMA(1, 1, At, B1); PG8_BAR; PG8_SCHED;
        }
        if (wr == 0) PG8_BAR;
        E(acc, cur, wr, wc, fr, fq);
        if (!has_next) break;
#pragma unroll
        for (int a = 0; a < 2; ++a)
#pragma unroll
            for (int b = 0; b < 2; ++b)
#pragma unroll
                for (int m = 0; m < 4; ++m)
#pragma unroll
                    for (int n = 0; n < 2; ++n) acc[a][b][m][n] = (f32x4){0.f, 0.f, 0.f, 0.f};
        cur = nxt; cB = nB; cA = nA; ++ui;
        if (wr == 1) PG8_BAR;
    }
    PG8_WAIT_V(0);
    PG8_BAR;
#undef PG8_SA
#undef PG8_SB
#undef PG8_STAGE
#undef PG8_STAGE_A
#undef PG8_LDA
#undef PG8_LDB
#undef PG8_MMA
#undef PG8_WAIT_V
#undef PG8_WAIT_L
#undef PG8_BAR
#undef PG8_SCHED
}
}

struct Args { const float* in[24]; float* out; unsigned char* ws; int ph_lo, ph_hi; };

__device__ __forceinline__ void p0_transpose_item(const float* W, int K, int N, bf16_t* WT, int k0, int n0, int rowbase, LAS float* scr, int lane) {
#pragma unroll 8
    for (int i = 0; i < 32; ++i) { const int kk = 2 * i + (lane >> 5); scr[kk * 33 + (lane & 31)] = W[(size_t)(k0 + kk) * N + n0 + (lane & 31)]; }
    asm volatile("s_waitcnt lgkmcnt(0)" ::: "memory");
    const int c = lane & 7;
#pragma unroll
    for (int j = 0; j < 4; ++j) { const int n = (lane >> 3) + 8 * j; const LAS float* s = scr + (8 * c) * 33 + n;
        u32x4 o; o.x = pk2(s[0 * 33], s[1 * 33]); o.y = pk2(s[2 * 33], s[3 * 33]); o.z = pk2(s[4 * 33], s[5 * 33]); o.w = pk2(s[6 * 33], s[7 * 33]);
        *(u32x4*)(WT + (size_t)(rowbase + n) * K + k0 + 8 * c) = o; }
    asm volatile("s_waitcnt lgkmcnt(0)" ::: "memory");
}
__device__ __forceinline__ void p0_transpose_item_fp8(const float* W, int K, int N, unsigned char* WT, int k0, int n0, int rowbase, float sc, LAS float* scr, int lane) {
#pragma unroll 8
    for (int i = 0; i < 64; ++i) { const int kk = 2 * i + (lane >> 5); scr[kk * 33 + (lane & 31)] = W[(size_t)(k0 + kk) * N + n0 + (lane & 31)]; }
    asm volatile("s_waitcnt lgkmcnt(0)" ::: "memory");
    const int c = lane & 7;
#pragma unroll
    for (int j = 0; j < 4; ++j) { const int n = (lane >> 3) + 8 * j; const LAS float* s = scr + (16 * c) * 33 + n;
        u32x4 o; o.x = pk4_fp8(s[0 * 33] * sc, s[1 * 33] * sc, s[2 * 33] * sc, s[3 * 33] * sc); o.y = pk4_fp8(s[4 * 33] * sc, s[5 * 33] * sc, s[6 * 33] * sc, s[7 * 33] * sc);
        o.z = pk4_fp8(s[8 * 33] * sc, s[9 * 33] * sc, s[10 * 33] * sc, s[11 * 33] * sc); o.w = pk4_fp8(s[12 * 33] * sc, s[13 * 33] * sc, s[14 * 33] * sc, s[15 * 33] * sc);
        *(u32x4*)(WT + (size_t)(rowbase + n) * K + k0 + 16 * c) = o; }
    asm volatile("s_waitcnt lgkmcnt(0)" ::: "memory");
}
__device__ __forceinline__ void p0_router_item(const float* W, bf16_t* WThi, bf16_t* WTlo, int k0, int n0, LAS float* scr, int lane) {
    constexpr int K = D, N = NE;
#pragma unroll 8
    for (int i = 0; i < 32; ++i) { const int kk = 2 * i + (lane >> 5); scr[kk * 33 + (lane & 31)] = W[(size_t)(k0 + kk) * N + n0 + (lane & 31)]; }
    asm volatile("s_waitcnt lgkmcnt(0)" ::: "memory");
    const int c = lane & 7;
#pragma unroll
    for (int j = 0; j < 4; ++j) { const int n = (lane >> 3) + 8 * j; const LAS float* s = scr + (8 * c) * 33 + n;
        unsigned hi[8], lo[8];
#pragma unroll
        for (int q = 0; q < 8; ++q) { const float v = s[q * 33]; hi[q] = f2bf(v); lo[q] = f2bf(v - __uint_as_float(hi[q] << 16)); }
        u32x4 oh, ol; oh.x = hi[0] | (hi[1] << 16); oh.y = hi[2] | (hi[3] << 16); oh.z = hi[4] | (hi[5] << 16); oh.w = hi[6] | (hi[7] << 16);
        ol.x = lo[0] | (lo[1] << 16); ol.y = lo[2] | (lo[3] << 16); ol.z = lo[4] | (lo[5] << 16); ol.w = lo[6] | (lo[7] << 16);
        *(u32x4*)(WThi + (size_t)(n0 + n) * K + k0 + 8 * c) = oh; *(u32x4*)(WTlo + (size_t)(n0 + n) * K + k0 + 8 * c) = ol; }
    asm volatile("s_waitcnt lgkmcnt(0)" ::: "memory");
}
__device__ __forceinline__ int win_rowbase(int n0) {
    if (n0 < 1024) return 256 * (n0 >> 7) + (n0 & 127);
    if (n0 < 2048) return 2048 + (n0 - 1024);
    if (n0 < 3072) { const int n = n0 - 2048; return 256 * (n >> 7) + 128 + (n & 127); }
    if (n0 < 4096) { const int n = n0 - 3072; return 3072 + 256 * (n >> 7) + (n & 127); }
    { const int n = n0 - 4096; return 3072 + 256 * (n >> 7) + 128 + (n & 127); }
}

__device__ __forceinline__ void build_tables(LAS unsigned char* lds, const unsigned* gcount, int& NBr) {
    LAS unsigned char* blk_e = lds + TBL_BLKE; LAS int* blkstart = (LAS int*)(lds + TBL_BSTART); LAS int* cnt = (LAS int*)(lds + TBL_CNT);
    const int tid = threadIdx.x;
    __syncthreads();
    if (tid < NE) cnt[tid] = (int)gcount[tid];
    __syncthreads();
    if (tid == 0) { int s = 0; for (int e = 0; e < NE; ++e) { blkstart[e] = s; s += (cnt[e] + 255) >> 8; } blkstart[NE] = s; }
    __syncthreads();
    NBr = blkstart[NE];
    if (tid < NE) { const int b0 = blkstart[tid], nb = (cnt[tid] + 255) >> 8; for (int i = 0; i < nb; ++i) blk_e[b0 + i] = (unsigned char)tid; }
    if (tid >= 64 && tid < 64 + 128) blk_e[NBr + tid - 64] = (unsigned char)NE;
    __syncthreads();
}


typedef const __attribute__((address_space(4))) Args* KArgsP;
__device__ __forceinline__ KArgsP kargs() { KArgsP p = (KArgsP)__builtin_amdgcn_kernarg_segment_ptr(); asm volatile("" : "+s"(p)); return p; }
#define WSP(type, name, off) type* name = (type*)(ws + (off))
__global__ void __launch_bounds__(NTHR, 2) fwd_kernel(Args args) {
    extern __shared__ __attribute__((aligned(16))) unsigned char lds_raw[];
    LAS unsigned char* lds = (LAS unsigned char*)lds_raw;
    volatile LAS unsigned* MISC = (volatile LAS unsigned*)(lds + MISC_OFF);
    const int tid = threadIdx.x, lane = tid & 63, wave = __builtin_amdgcn_readfirstlane(tid >> 6);
    const int G = gridDim.x, bx = blockIdx.x;
    const int vcu = (G % 8 == 0) ? (bx % 8) * (G / 8) + bx / 8 : bx;
    unsigned* ctl = (unsigned*)(args.ws + WS_CTL);
    for (int u = tid; u < (LDS_BYTES - MISC_OFF) / 4; u += NTHR) ((LAS unsigned*)(lds + MISC_OFF))[u] = 0u;
    __syncthreads();
    XcdBarrier bar; bar.bar = ctl + CW_BAR; bar.x = 0; bar.st = nullptr;
    if (MK_N_LAUNCHES == 1) bar = xcd_barrier_post(ctl + CW_BAR, MISC + 8);
    const int lo = args.ph_lo, hi = args.ph_hi;
#ifndef PH_MASK
#define PH_MASK 0x1ff
#endif
#define IN(k) ((((PH_MASK) >> (k)) & 1) && lo <= (k) && (k) < hi)
#define SEAM(k) do { if (IN(k) && IN((k) + 1)) xcd_barrier(bar); } while (0)

    if (IN(0)) {
        KArgsP ap = kargs(); unsigned char* ws = ap->ws;
        const float* cvec = ap->in[1]; const float* w_ada = ap->in[2]; const float* b_ada = ap->in[3];
        WSP(float, mod, WS_MOD);
        {
            LAS float* cs = (LAS float*)lds;
            for (int it = bx; it < 192; it += G) {
                __syncthreads();
                for (int i = tid; i < NB_ * D; i += NTHR) { const float v = cvec[i]; cs[i] = v / (1.0f + expf(-v)); }
                __syncthreads();
                const int n0 = 64 * it, cg = tid & 15, rl = tid >> 4;
                float a[16][4];
#pragma unroll
                for (int b = 0; b < 16; ++b) { a[b][0] = 0.f; a[b][1] = 0.f; a[b][2] = 0.f; a[b][3] = 0.f; }
#pragma unroll 2
                for (int kk = rl; kk < D; kk += 32) {
                    const f32x4 w4 = *(const f32x4*)(w_ada + (size_t)kk * (6 * D) + n0 + 4 * cg);
#pragma unroll
                    for (int b = 0; b < 16; ++b) { const float s = cs[b * D + kk]; a[b][0] += s * w4[0]; a[b][1] += s * w4[1]; a[b][2] += s * w4[2]; a[b][3] += s * w4[3]; }
                }
#pragma unroll
                for (int b = 0; b < 16; ++b)
#pragma unroll
                    for (int c = 0; c < 4; ++c) { float v = a[b][c]; v += __shfl_xor(v, 16); v += __shfl_xor(v, 32); a[b][c] = v; }
                __syncthreads();
                LAS float* red = (LAS float*)lds;
                if (lane < 16) {
#pragma unroll
                    for (int b = 0; b < 16; ++b)
#pragma unroll
                        for (int c = 0; c < 4; ++c) red[(wave * 16 + b) * 64 + 4 * cg + c] = a[b][c];
                }
                __syncthreads();
                for (int o = tid; o < 16 * 64; o += NTHR) { const int b = o >> 6, c = o & 63; float s = b_ada[n0 + c];
#pragma unroll
                    for (int w = 0; w < 8; ++w) s += red[(w * 16 + b) * 64 + c];
                    mod[(size_t)b * (6 * D) + n0 + c] = s; }
            }
            __syncthreads();
        }
        {
            const float* w_in = ap->in[5]; const float* w_out = ap->in[13]; const float* w_router = ap->in[15];
            const float* w_gate = ap->in[17]; const float* w_up = ap->in[18]; const float* w_down = ap->in[19];
            const float* ws_gate = ap->in[20]; const float* ws_up = ap->in[21]; const float* ws_down = ap->in[22];
            WSP(bf16_t, WrThi, WS_WRT); bf16_t* WrTlo = WrThi + (size_t)NE * D;
            WSP(unsigned char, W2T, WS_W2T); WSP(unsigned char, W1T, WS_W1T); WSP(bf16_t, WinT, WS_WINT); WSP(bf16_t, WoutT, WS_WOUTT);
            LAS float* scr = (LAS float*)(lds + wave * 16896);
            static_assert(NWAVES * 16896 <= MISC_OFF, "P0 scratch");
            const int gw = vcu * NWAVES + wave, NGW = G * NWAVES;
            constexpr int I_IN = 16 * 160, I_OUT = 16 * 64, I_GU = 16 * 16, I_DN = 4 * 64, I_RT = 32 * 2;
            constexpr int NITEMS = I_IN + I_OUT + 65 * 2 * I_GU + 65 * I_DN + I_RT;
            for (int it = gw; it < NITEMS; it += NGW) {
                int r = it;
                if (r < I_IN) { const int kb = r / 160, nb = r % 160; p0_transpose_item_fp8(w_in, D, NPROJ, (unsigned char*)WinT, 128 * kb, 32 * nb, win_rowbase(32 * nb), SC_WI, scr, lane); continue; } r -= I_IN;
                if (r < I_OUT) { const int kb = r / 64, nb = r % 64; p0_transpose_item_fp8(w_out, D, D, (unsigned char*)WoutT, 128 * kb, 32 * nb, 32 * nb, SC_WO, scr, lane); continue; } r -= I_OUT;
                if (r < 65 * 2 * I_GU) { const int e = r / (2 * I_GU), r2 = r % (2 * I_GU), isup = r2 / I_GU, r3 = r2 % I_GU, kb = r3 / 16, nb = r3 % 16, n0 = 32 * nb;
                    const float* W = (e < NE) ? ((isup ? w_up : w_gate) + (size_t)e * D * FE) : (isup ? ws_up : ws_gate);
                    p0_transpose_item_fp8(W, D, FE, W1T + (size_t)e * 1024 * D, 128 * kb, n0, 256 * (n0 >> 7) + 128 * isup + (n0 & 127), SC_W1, scr, lane); continue; } r -= 65 * 2 * I_GU;
                if (r < 65 * I_DN) { const int e = r / I_DN, r3 = r % I_DN, kb = r3 / 64, nb = r3 % 64;
                    const float* W = (e < NE) ? (w_down + (size_t)e * FE * D) : ws_down;
                    p0_transpose_item_fp8(W, FE, D, W2T + (size_t)e * D * FE, 128 * kb, 32 * nb, 32 * nb, SC_W2, scr, lane); continue; } r -= 65 * I_DN;
                { const int kb = r / 2, nb = r % 2; p0_router_item(w_router, WrThi, WrTlo, 64 * kb, 32 * nb, scr, lane); }
            }
        }
    }
    SEAM(0);

    if (IN(1)) {
        KArgsP ap = kargs(); unsigned char* ws = ap->ws;
        const float* x = ap->in[0]; const float* norm_mix_g = ap->in[4];
        WSP(float, mod, WS_MOD); WSP(bf16_t, Hb, WS_H);
        LAS float* Av = (LAS float*)lds; LAS float* Bv = Av + D;
        for (int ch = bx; ch < T / 128; ch += G) {
            const int b = ch >> 4; const float* mb = mod + (size_t)b * (6 * D);
            __syncthreads();
            for (int k = tid; k < D; k += NTHR) { Av[k] = norm_mix_g[k] * (1.0f + mb[D + k]); Bv[k] = mb[k]; }
            __syncthreads();
            for (int rr = 0; rr < 16; rr += 2) {
                const int row = ch * 128 + wave * 16 + rr;
                const f32x4* xr0 = (const f32x4*)(x + (size_t)row * D) + lane; const f32x4* xr1 = xr0 + D / 4;
                f32x4 v0[8], v1[8]; float s0 = 0.f, s1 = 0.f;
#pragma unroll
                for (int j = 0; j < 8; ++j) { v0[j] = xr0[64 * j]; v1[j] = xr1[64 * j]; }
#pragma unroll
                for (int j = 0; j < 8; ++j) { s0 += (v0[j][0] * v0[j][0] + v0[j][1] * v0[j][1]) + (v0[j][2] * v0[j][2] + v0[j][3] * v0[j][3]);
                                              s1 += (v1[j][0] * v1[j][0] + v1[j][1] * v1[j][1]) + (v1[j][2] * v1[j][2] + v1[j][3] * v1[j][3]); }
                const float rstd0 = rsq(wave_sum(s0) * (1.0f / D) + EPS), rstd1 = rsq(wave_sum(s1) * (1.0f / D) + EPS);
                unsigned* o0 = (unsigned*)((unsigned char*)Hb + (size_t)row * D) + lane; unsigned* o1 = o0 + D / 4;
#pragma unroll
                for (int j = 0; j < 8; ++j) { const f32x4 a4 = *(const LAS f32x4*)(Av + 256 * j + 4 * lane), b4 = *(const LAS f32x4*)(Bv + 256 * j + 4 * lane);
                    const f32x4 h0 = (v0[j] * rstd0 * a4 + b4) * SC_H, h1 = (v1[j] * rstd1 * a4 + b4) * SC_H;
                    o0[64 * j] = pk4_fp8(h0[0], h0[1], h0[2], h0[3]); o1[64 * j] = pk4_fp8(h1[0], h1[1], h1[2], h1[3]); }
            }
        }
        __syncthreads();
    }
    SEAM(1);

    if (IN(2)) {
        KArgsP ap = kargs(); unsigned char* ws = ap->ws;
        WSP(bf16_t, WinT, WS_WINT); WSP(bf16_t, Hb, WS_H); WSP(bf16_t, Ub, WS_UBG); bf16_t* BAb = Ub + (size_t)T * DA; bf16_t* GLUb = BAb + (size_t)T * DA;
        pg8::DenseOrderG S; S.init(T, NPROJ, D, G, bx, WinT);
        pg8::EpiProj E{Ub, BAb, GLUb};
        pg8::gemm_phase<true, pg8::EpiProj, pg8::DenseOrderG>(lds, Hb, (unsigned)T * D, WinT, (unsigned)NPROJ * D, D, S, E);
    }
    SEAM(2);

    if (IN(3)) {
        KArgsP ap = kargs(); unsigned char* ws = ap->ws;
        const float* conv_a_w = ap->in[6]; const float* conv_b_w = ap->in[7]; const float* conv_b_b = ap->in[8];
        const float* ln_b_g = ap->in[9]; const float* ln_b_b = ap->in[10]; const float* hn_a_g = ap->in[11]; const float* hn_b_g = ap->in[12];
        WSP(bf16_t, Hb, WS_H); WSP(bf16_t, Ub, WS_UBG); bf16_t* BAb = Ub + (size_t)T * DA; bf16_t* GLUb = BAb + (size_t)T * DA;
        constexpr int CT = 32, NR = CT + 30, NRW = (NR + 7) / 8;
        LAS unsigned char* gt = lds;
        LAS unsigned short* zl = (LAS unsigned short*)(lds + 65536);
        static_assert(NR * 1024 <= 65536 && 65536 + CT * 1024 * 2 <= RING_BYTES, "P3 LDS map");
        constexpr int NCH = T / CT;
        u32x4 R[NRW];
#define P3_LOAD_TILE(chunk, pass) do { const int _t0 = (chunk) * CT, _tp = _t0 & (SEQ - 1); _Pragma("unroll") for (int _i = 0; _i < NRW; ++_i) { const int _r = wave + 8 * _i; \
            R[_i] = (u32x4){0u, 0u, 0u, 0u}; if (_r < NR && _tp - 30 + _r >= 0) R[_i] = *(const u32x4*)(GLUb + (size_t)(_t0 - 30 + _r) * DA + 512 * (pass) + 8 * lane); } } while (0)
#define P3_STORE_TILE() do { _Pragma("unroll") for (int _i = 0; _i < NRW; ++_i) { const int _r = wave + 8 * _i; if (_r < NR) *(LAS u32x4*)(gt + _r * 1024 + 16 * lane) = R[_i]; } } while (0)
#define P3_LOAD_W(pass) do { _Pragma("unroll") for (int _j = 0; _j < 31; ++_j) wv[_j] = __uint_as_float(__builtin_amdgcn_raw_buffer_load_b32(rsW, (tid + 512 * (pass)) * 4, _j * DA * 4, 0)); bias = conv_b_b[tid + 512 * (pass)]; } while (0)
#define P3_CONV(pass) do { float xv[NR]; _Pragma("unroll") for (int _i = 0; _i < NR; ++_i) xv[_i] = __uint_as_float(((unsigned)*(const LAS unsigned short*)(gt + _i * 1024 + 2 * tid)) << 16); \
            float _o[CT]; _Pragma("unroll") for (int _i = 0; _i < CT; ++_i) _o[_i] = bias; \
            _Pragma("unroll") for (int _j = 0; _j < 31; ++_j) _Pragma("unroll") for (int _i = 0; _i < CT; ++_i) _o[_i] = __builtin_fmaf(wv[_j], xv[_i + _j], _o[_i]);     \
            _Pragma("unroll") for (int _i = 0; _i < CT; ++_i) zl[_i * DA + tid + 512 * (pass)] = (unsigned short)pk2(_o[_i], 0.f); } while (0)
        float wv[31], bias;
        const __amdgpu_buffer_rsrc_t rsW = __builtin_amdgcn_make_buffer_rsrc((void*)conv_b_w, 0, 31 * DA * 4, 0x00020000);
        if (bx < NCH) { P3_LOAD_TILE(bx, 0); P3_STORE_TILE(); }
        for (int ch = bx; ch < NCH; ch += G) {
            const int t0 = ch * CT, tpos = t0 & (SEQ - 1), nxt = ch + G;
            P3_LOAD_W(0);
            __syncthreads();
            P3_LOAD_TILE(ch, 1);
            P3_CONV(0);
            P3_LOAD_W(1);
            __syncthreads();
            P3_STORE_TILE();
            __syncthreads();
            if (nxt < NCH) P3_LOAD_TILE(nxt, 0);
            P3_CONV(1);
            __syncthreads();
            if (nxt < NCH) P3_STORE_TILE();
            f32x4 lng[4], lnb[4], hnb[4], hna[4], cw0[4], cw1[4], cw2[4];
#pragma unroll
            for (int j = 0; j < 4; ++j) { const int c = 256 * j + 4 * lane;
                lng[j] = *(const f32x4*)(ln_b_g + c); lnb[j] = *(const f32x4*)(ln_b_b + c); hnb[j] = *(const f32x4*)(hn_b_g + c); hna[j] = *(const f32x4*)(hn_a_g + c);
                cw0[j] = *(const f32x4*)(conv_a_w + c); cw1[j] = *(const f32x4*)(conv_a_w + DA + c); cw2[j] = *(const f32x4*)(conv_a_w + 2 * DA + c); }
#pragma unroll 2
            for (int ii = 0; ii < CT / 8; ++ii) {
                const int i = (CT / 8) * wave + ii, t = t0 + i, tp = tpos + i;
                u32x2 pu0[4], pu1[4], pu2[4], pbb[4];
#pragma unroll
                for (int j = 0; j < 4; ++j) { const int c = 256 * j + 4 * lane;
                    pu0[j] = *(const u32x2*)(Ub + (size_t)t * DA + c); pbb[j] = *(const u32x2*)(BAb + (size_t)t * DA + c);
                    pu1[j] = (u32x2){0u, 0u}; pu2[j] = (u32x2){0u, 0u};
                    if (tp >= 1) pu1[j] = *(const u32x2*)(Ub + (size_t)(t - 1) * DA + c);
                    if (tp >= 2) pu2[j] = *(const u32x2*)(Ub + (size_t)(t - 2) * DA + c); }
                f32x4 z[4]; float s = 0.f;
#pragma unroll
                for (int j = 0; j < 4; ++j) { const u32x2 zq = *(const LAS u32x2*)(zl + i * DA + 256 * j + 4 * lane); z[j] = (f32x4){bflo(zq.x), bfhi(zq.x), bflo(zq.y), bfhi(zq.y)}; s += (z[j][0] + z[j][1]) + (z[j][2] + z[j][3]); }
                const float mean = wave_sum(s) * (1.0f / DA); float q = 0.f;
#pragma unroll
                for (int j = 0; j < 4; ++j) { z[j] = z[j] - mean; q += (z[j][0] * z[j][0] + z[j][1] * z[j][1]) + (z[j][2] * z[j][2] + z[j][3] * z[j][3]); }
                const float rstd = rsq(wave_sum(q) * (1.0f / DA) + EPS);
                unsigned char* yrow = (unsigned char*)Hb + (size_t)t * D;
#pragma unroll
                for (int j = 0; j < 4; ++j) {
                    f32x4 v = z[j] * rstd * lng[j] + lnb[j]; float ss = 0.f;
#pragma unroll
                    for (int e = 0; e < 4; ++e) { v[e] = v[e] * fast_sigmoid(v[e]); ss += v[e] * v[e]; }
                    ss = row_sum16(ss);
                    const float r = rsq(ss * (1.0f / 64.0f) + EPS);
                    const f32x4 o = v * (r * SC_YM) * hnb[j];
                    *(unsigned*)(yrow + DA + 256 * j + 4 * lane) = pk4_fp8(o[0], o[1], o[2], o[3]);
                }
#pragma unroll
                for (int j = 0; j < 4; ++j) { const int c = 256 * j + 4 * lane;
                    const u32x2 u0 = pu0[j], u1 = pu1[j], u2 = pu2[j], bb = pbb[j];
                    f32x4 U0 = (f32x4){bflo(u0.x), bfhi(u0.x), bflo(u0.y), bfhi(u0.y)}, U1 = (f32x4){bflo(u1.x), bfhi(u1.x), bflo(u1.y), bfhi(u1.y)}, U2 = (f32x4){bflo(u2.x), bfhi(u2.x), bflo(u2.y), bfhi(u2.y)};
                    const f32x4 Bq = (f32x4){bflo(bb.x), bfhi(bb.x), bflo(bb.y), bfhi(bb.y)};
                    const f32x4 ya = Bq * (cw0[j] * U2 + cw1[j] * U1 + cw2[j] * U0);
                    float ss = (ya[0] * ya[0] + ya[1] * ya[1]) + (ya[2] * ya[2] + ya[3] * ya[3]);
                    ss = row_sum16(ss);
                    const float r = rsq(ss * (1.0f / 64.0f) + EPS);
                    const f32x4 o = ya * (r * SC_YM) * hna[j];
                    *(unsigned*)(yrow + c) = pk4_fp8(o[0], o[1], o[2], o[3]); }
            }
        }
        __syncthreads();
    }
#undef P3_LOAD_TILE
#undef P3_STORE_TILE
#undef P3_LOAD_W
#undef P3_CONV
    SEAM(3);

    if (IN(4)) {
        KArgsP ap = kargs(); unsigned char* ws = ap->ws;
        const float* x = ap->in[0];
        WSP(float, mod, WS_MOD); WSP(float, ssq, WS_SSQ); WSP(bf16_t, WoutT, WS_WOUTT); WSP(bf16_t, Hb, WS_H); WSP(bf16_t, X2, WS_X2);
        pg8::DenseOrderG S; S.init(T, D, D, G, bx, WoutT);
        pg8::EpiOut E{x, mod, X2, ssq};
        pg8::gemm_phase<true, pg8::EpiOut, pg8::DenseOrderG>(lds, Hb, (unsigned)T * D, WoutT, (unsigned)D * D, D, S, E);
    }
    SEAM(4);

    if (IN(5)) {
        KArgsP ap = kargs(); unsigned char* ws = ap->ws;
        const float* norm_ffn_g = ap->in[14]; const float* router_bias = ap->in[16]; WSP(bf16_t, X2, WS_X2);
        WSP(float, mod, WS_MOD); WSP(float, ssq, WS_SSQ); WSP(int, tok_e, WS_TOKE); WSP(int, tok_r, WS_TOKR); WSP(float, tok_w, WS_TOKW); WSP(int, inv_tok, WS_INVT);
        WSP(bf16_t, WrThi, WS_WRT); bf16_t* WrTlo = WrThi + (size_t)NE * D; WSP(unsigned char, H2, WS_H2);
        unsigned* gcount = (unsigned*)(ws + WS_CTL) + CW_GCOUNT;
        LAS float* gsc = (LAS float*)lds; LAS float* shv = gsc + D;
        LAS unsigned char* slab = lds + 16384;
        LAS float* Sc = (LAS float*)(lds + 16384);
        LAS float* Mk = Sc + 128 * 65;
        LAS float* rbias = (LAS float*)(lds + 16384 + 65536 + 4096);
        LAS int* lcnt = (LAS int*)(rbias + 64); LAS int* lbase = lcnt + 64;
        for (int ch = bx; ch < T / 128; ch += G) {
            const int b = ch >> 4; const float* mb = mod + (size_t)b * (6 * D);
            __syncthreads();
            for (int k = tid; k < D; k += NTHR) { gsc[k] = norm_ffn_g[k] * (1.0f + mb[4 * D + k]); shv[k] = mb[3 * D + k]; }
            if (tid < NE) { rbias[tid] = router_bias[tid]; lcnt[tid] = 0; }
            __syncthreads();
            {
                const int r = lane & 15, q = lane >> 4, t = ch * 128 + wave * 16 + r;
                float s = 0.f;
#pragma unroll
                for (int p = 0; p < 8; ++p) s += ssq[(size_t)(q * 8 + p) * T + t];
                s += __shfl_xor(s, 16); s += __shfl_xor(s, 32);
                const float rstd = rsq(s * (1.0f / D) + EPS);
                f32x4 acc[4];
#pragma unroll
                for (int n = 0; n < 4; ++n) acc[n] = (f32x4){0.f, 0.f, 0.f, 0.f};
                const bf16_t* xrow = X2 + (size_t)t * D + 8 * q;
                unsigned char* hrow = H2 + (size_t)t * D + 8 * q;
                u32x4 xq[4];
#pragma unroll
                for (int s = 0; s < 4; ++s) xq[s] = *(const u32x4*)(xrow + 32 * s);
                unsigned sdst[4]; const bf16_t* ssrc[4];
#pragma unroll
                for (int j = 0; j < 4; ++j) { const int p = tid + 512 * j, hl = p >> 10, e = (p >> 4) & 63, kc = p & 15; const int ob = (e & 15) * 64 + (kc & 3) * 16;
                    sdst[j] = (unsigned)(((hl * 4 + (kc >> 2)) * 4 + (e >> 4)) * 1024 + (ob ^ (((ob >> 9) & 1) << 5))); ssrc[j] = (hl ? WrTlo : WrThi) + (size_t)e * D + 8 * kc; }
                const int fo = r * 64 + q * 16, foff = fo ^ (((fo >> 9) & 1) << 5);
                u32x4 sreg[4];
#pragma unroll
                for (int j = 0; j < 4; ++j) sreg[j] = *(const u32x4*)(ssrc[j]);
#pragma unroll
                for (int j = 0; j < 4; ++j) *(LAS u32x4*)(slab + sdst[j]) = sreg[j];
                __syncthreads();
#pragma unroll 1
                for (int k0 = 0; k0 < D; k0 += 128) {
                    const int it = k0 >> 7; LAS unsigned char* sb = slab + (it & 1) * 32768;
                    const int kn = (k0 + 128 < D) ? k0 + 128 : k0;
#pragma unroll
                    for (int j = 0; j < 4; ++j) sreg[j] = *(const u32x4*)(ssrc[j] + kn);
#pragma unroll
                    for (int s = 0; s < 4; ++s) {
                        const int kk = k0 + 32 * s;
                        const f32x4 ga = *(const LAS f32x4*)(gsc + kk + 8 * q), gb = *(const LAS f32x4*)(gsc + kk + 8 * q + 4);
                        const f32x4 sa = *(const LAS f32x4*)(shv + kk + 8 * q), sb4 = *(const LAS f32x4*)(shv + kk + 8 * q + 4);
                        const f32x4 xa4 = (f32x4){bflo(xq[s].x), bfhi(xq[s].x), bflo(xq[s].y), bfhi(xq[s].y)}, xb4 = (f32x4){bflo(xq[s].z), bfhi(xq[s].z), bflo(xq[s].w), bfhi(xq[s].w)};
                        const f32x4 ha = xa4 * rstd * ga + sa, hb = xb4 * rstd * gb + sb4;
                        const int kx = (kk + 128 < D) ? kk + 128 : kk;
                        xq[s] = *(const u32x4*)(xrow + kx);
                        u32x4 ph, pl;
                        ph.x = pk2(ha[0], ha[1]); ph.y = pk2(ha[2], ha[3]); ph.z = pk2(hb[0], hb[1]); ph.w = pk2(hb[2], hb[3]);
                        pl.x = pk2(ha[0] - bflo(ph.x), ha[1] - bfhi(ph.x)); pl.y = pk2(ha[2] - bflo(ph.y), ha[3] - bfhi(ph.y));
                        pl.z = pk2(hb[0] - bflo(ph.z), hb[1] - bfhi(ph.z)); pl.w = pk2(hb[2] - bflo(ph.w), hb[3] - bfhi(ph.w));
                        { u32x2 h8; h8.x = pk4_fp8(ha[0] * SC_H2, ha[1] * SC_H2, ha[2] * SC_H2, ha[3] * SC_H2); h8.y = pk4_fp8(hb[0] * SC_H2, hb[1] * SC_H2, hb[2] * SC_H2, hb[3] * SC_H2); *(u32x2*)(hrow + kk) = h8; }
                        const bf16x8 Ah = __builtin_bit_cast(bf16x8, ph), Al = __builtin_bit_cast(bf16x8, pl);
#pragma unroll
                        for (int n = 0; n < 4; ++n) {
                            const bf16x8 Bh = *(const LAS bf16x8*)(sb + ((0 * 4 + s) * 4 + n) * 1024 + foff), Bl = *(const LAS bf16x8*)(sb + ((1 * 4 + s) * 4 + n) * 1024 + foff);
                            acc[n] = __builtin_amdgcn_mfma_f32_16x16x32_bf16(Bh, Ah, acc[n], 0, 0, 0);
                            acc[n] = __builtin_amdgcn_mfma_f32_16x16x32_bf16(Bl, Ah, acc[n], 0, 0, 0);
                            acc[n] = __builtin_amdgcn_mfma_f32_16x16x32_bf16(Bh, Al, acc[n], 0, 0, 0);
                        }
                    }
#pragma unroll
                    for (int j = 0; j < 4; ++j) *(LAS u32x4*)(slab + ((it + 1) & 1) * 32768 + sdst[j]) = sreg[j];
                    __syncthreads();
                }
#pragma unroll
                for (int n = 0; n < 4; ++n)
#pragma unroll
                    for (int i = 0; i < 4; ++i) Sc[(wave * 16 + r) * 65 + 16 * n + 4 * q + i] = 1.0f / (1.0f + expf(-acc[n][i]));
            }
            __syncthreads();
            int idx[TOPK]; float wk[TOPK]; int lr[TOPK];
            const int tl = tid;
            if (tid < 128) {
                LAS float* srow = Sc + tl * 65; LAS float* mrow = Mk + tl * 65;
                float gs[8];
#pragma unroll
                for (int g = 0; g < 8; ++g) { float m1 = -INFINITY, m2 = -INFINITY;
#pragma unroll
                    for (int j = 0; j < 8; ++j) { const float v = srow[8 * g + j] + rbias[8 * g + j]; mrow[8 * g + j] = v; if (v > m1) { m2 = m1; m1 = v; } else if (v > m2) m2 = v; }
                    gs[g] = m1 + m2; }
                unsigned sel = 0u;
#pragma unroll
                for (int g = 0; g < 8; ++g) { int rank = 0;
#pragma unroll
                    for (int h = 0; h < 8; ++h) rank += (gs[h] > gs[g] || (gs[h] == gs[g] && h < g)) ? 1 : 0;
                    if (rank < 4) sel |= 1u << g; }
#pragma unroll
                for (int g = 0; g < 8; ++g) if (!((sel >> g) & 1u)) {
#pragma unroll
                    for (int j = 0; j < 8; ++j) mrow[8 * g + j] = -INFINITY; }
                float wsum = 0.f;
#pragma unroll
                for (int k = 0; k < TOPK; ++k) { float best = -INFINITY; int bi = 0;
#pragma unroll 8
                    for (int e = 0; e < NE; ++e) { const float v = mrow[e]; if (v > best) { best = v; bi = e; } }
                    mrow[bi] = -INFINITY; idx[k] = bi; wk[k] = srow[bi]; wsum += wk[k]; }
                const float inv = 2.5f / wsum;
#pragma unroll
                for (int k = 0; k < TOPK; ++k) { wk[k] *= inv; lr[k] = atomicAdd((int*)&lcnt[idx[k]], 1); }
            }
            __syncthreads();
            if (tid < NE) lbase[tid] = (int)atomicAdd(&gcount[tid], (unsigned)lcnt[tid]);
            __syncthreads();
            if (tid < 128) { const int t = ch * 128 + tl;
#pragma unroll
                for (int k = 0; k < TOPK; ++k) { const int e = idx[k], rank = lbase[e] + lr[k];
                    tok_e[t * 8 + k] = e; tok_r[t * 8 + k] = rank; tok_w[t * 8 + k] = wk[k]; inv_tok[e * T + rank] = t; }
                inv_tok[NE * T + t] = t; }
        }
        __syncthreads();
    }
    SEAM(5);

    if (IN(6)) {
        KArgsP ap = kargs(); unsigned char* ws = ap->ws;
        WSP(int, inv_tok, WS_INVT); WSP(unsigned char, W1T, WS_W1T); WSP(unsigned char, H2, WS_H2); WSP(unsigned char, ACT, WS_ACT);
        unsigned* gcount = (unsigned*)(ws + WS_CTL) + CW_GCOUNT;
        int NBr; build_tables(lds, gcount, NBr);
        pg8::MoeOrder<0, 4> S; S.blk_e = lds + TBL_BLKE; S.blkstart = (const LAS int*)(lds + TBL_BSTART); S.cnt = (const LAS int*)(lds + TBL_CNT);
        S.NB = NBr + 128; S.G = G; S.vcu = vcu; S.KB = D; S.Bt = W1T; S.estride = 1024u * D; S.boff0 = 0; S.inv_tok = inv_tok;
        pg8::EpiAct E{ACT};
        pg8::gemm_phase<true, pg8::EpiAct, pg8::MoeOrder<0, 4>>(lds, H2, (unsigned)T * D, W1T, 65u * 1024u * D, D, S, E);
    }
    SEAM(6);

    if (IN(7)) {
        KArgsP ap = kargs(); unsigned char* ws = ap->ws;
        WSP(int, inv_tok, WS_INVT); WSP(unsigned char, W2T, WS_W2T); WSP(unsigned char, ACT, WS_ACT); WSP(unsigned char, YR, WS_Y);
        unsigned* gcount = (unsigned*)(ws + WS_CTL) + CW_GCOUNT;
        int NBr; build_tables(lds, gcount, NBr);
        pg8::MoeOrder<1, 8> S; S.blk_e = lds + TBL_BLKE; S.blkstart = (const LAS int*)(lds + TBL_BSTART); S.cnt = (const LAS int*)(lds + TBL_CNT);
        S.NB = NBr + 128; S.G = G; S.vcu = vcu; S.KB = FE; S.Bt = W2T; S.estride = (unsigned)D * FE; S.boff0 = 0; S.inv_tok = inv_tok;
        pg8::EpiY8 E{YR};
        pg8::gemm_phase<true, pg8::EpiY8, pg8::MoeOrder<1, 8>>(lds, ACT, (unsigned)MAXBLK * 256 * FE, W2T, 65u * D * FE, FE, S, E);
    }
    SEAM(7);

    if (IN(8)) {
        KArgsP ap = kargs(); unsigned char* ws = ap->ws;
        const float* norm_final_g = ap->in[23]; float* out = ap->out;
        WSP(float, mod, WS_MOD); WSP(int, tok_e, WS_TOKE); WSP(int, tok_r, WS_TOKR); WSP(float, tok_w, WS_TOKW); WSP(unsigned char, YR, WS_Y); WSP(bf16_t, X2, WS_X2);
        unsigned* gcount = (unsigned*)(ws + WS_CTL) + CW_GCOUNT;
        int NBr; build_tables(lds, gcount, NBr);
        const LAS int* blkstart = (const LAS int*)(lds + TBL_BSTART);
        const int tstride = G * NWAVES;
        for (int t0 = vcu * NWAVES + wave; t0 < T; t0 += 2 * tstride) {
            int tt[2]; tt[0] = t0; tt[1] = (t0 + tstride < T) ? t0 + tstride : t0;
            f32x4 a[2][4][2];
#pragma unroll
            for (int u = 0; u < 2; ++u)
#pragma unroll
                for (int j = 0; j < 4; ++j) { a[u][j][0] = (f32x4){0.f, 0.f, 0.f, 0.f}; a[u][j][1] = (f32x4){0.f, 0.f, 0.f, 0.f}; }
#pragma unroll 3
            for (int k = 0; k < TOPK + 1; ++k) {
#pragma unroll
                for (int u = 0; u < 2; ++u) { const int t = tt[u];
                    int row; float w; constexpr float ys = 1.0f / SC_Y;
                    if (k < TOPK) { const int e = tok_e[t * 8 + k]; row = 256 * blkstart[e] + tok_r[t * 8 + k]; w = tok_w[t * 8 + k] * ys; } else { row = 256 * NBr + t; w = ys; }
                    const unsigned char* yr = YR + (size_t)row * D + 8 * lane;
#pragma unroll
                    for (int j = 0; j < 4; ++j) { const u32x2 y2 = *(const u32x2*)(yr + 512 * j);
                        const f32x2 p0 = __builtin_amdgcn_cvt_pk_f32_fp8((int)y2.x, false), p1 = __builtin_amdgcn_cvt_pk_f32_fp8((int)y2.x, true);
                        const f32x2 p2 = __builtin_amdgcn_cvt_pk_f32_fp8((int)y2.y, false), p3 = __builtin_amdgcn_cvt_pk_f32_fp8((int)y2.y, true);
                        a[u][j][0] = a[u][j][0] + w * (f32x4){p0.x, p0.y, p1.x, p1.y}; a[u][j][1] = a[u][j][1] + w * (f32x4){p2.x, p2.y, p3.x, p3.y}; } }
            }
#pragma unroll
            for (int u = 0; u < 2; ++u) { const int t = tt[u]; const int b = t >> 11; const float* gf = mod + (size_t)b * (6 * D) + 5 * D;
                float* orow = out + (size_t)t * D; const bf16_t* xrow = X2 + (size_t)t * D;
                float ss = 0.f;
#pragma unroll
                for (int j = 0; j < 4; ++j) { const u32x4 xq = *(const u32x4*)(xrow + 512 * j + 8 * lane);
#pragma unroll
                    for (int h = 0; h < 2; ++h) { const int c = 512 * j + 8 * lane + 4 * h; const unsigned q0 = h ? xq.z : xq.x, q1 = h ? xq.w : xq.y;
                        const f32x4 xv = (f32x4){bflo(q0), bfhi(q0), bflo(q1), bfhi(q1)}, g4 = *(const f32x4*)(gf + c);
                        a[u][j][h] = xv + g4 * a[u][j][h]; ss += (a[u][j][h][0] * a[u][j][h][0] + a[u][j][h][1] * a[u][j][h][1]) + (a[u][j][h][2] * a[u][j][h][2] + a[u][j][h][3] * a[u][j][h][3]); } }
                const float rstd = rsq(wave_sum(ss) * (1.0f / D) + EPS);
#pragma unroll
                for (int j = 0; j < 4; ++j)
#pragma unroll
                    for (int h = 0; h < 2; ++h) { const int c = 512 * j + 8 * lane + 4 * h; const f32x4 g0 = *(const f32x4*)(norm_final_g + c); *(f32x4*)(orow + c) = a[u][j][h] * rstd * g0; }
            }
        }
    }
#undef IN
#undef SEAM
}

extern "C" void kernel_launch(void* const* d_in, const int* in_sizes, int n_in, void* d_out, int out_size, void* d_ws, size_t ws_size, hipStream_t stream) {
    static int grid = 0;
    if (grid == 0) {
        if (n_in != 24 || out_size != T * D || ws_size < WS_END) { fprintf(stderr, "kernel_launch: unexpected problem (n_in %d, out %d, ws %zu)\n", n_in, out_size, ws_size); grid = -1; return; }
        int dev = 0, cus = 0, per_cu = 0;
        if (hipGetDevice(&dev) != hipSuccess || hipDeviceGetAttribute(&cus, hipDeviceAttributeMultiprocessorCount, dev) != hipSuccess) { grid = -1; return; }
        if (hipFuncSetAttribute((const void*)fwd_kernel, hipFuncAttributeMaxDynamicSharedMemorySize, LDS_BYTES) != hipSuccess) { fprintf(stderr, "kernel_launch: hipFuncSetAttribute failed\n"); grid = -1; return; }
        if (hipOccupancyMaxActiveBlocksPerMultiprocessor(&per_cu, (const void*)fwd_kernel, NTHR, LDS_BYTES) != hipSuccess || per_cu < 1) { fprintf(stderr, "kernel_launch: occupancy query says %d\n", per_cu); }
        (void)hipGetLastError();
        grid = cus;
    }
    if (grid < 0) return;
    (void)hipMemsetAsync((char*)d_ws + WS_CTL, 0, CTL_ZERO_BYTES, stream);
    Args a{};
    for (int i = 0; i < 24; ++i) a.in[i] = (const float*)d_in[i];
    a.out = (float*)d_out; a.ws = (unsigned char*)d_ws;
    constexpr int NPH = 9;
    if (MK_N_LAUNCHES == 1) {
        a.ph_lo = 0; a.ph_hi = NPH;
        hipLaunchKernelGGL(fwd_kernel, dim3(grid), dim3(NTHR), LDS_BYTES, stream, a);
    } else {
        for (int p = 0; p < NPH; ++p) { const int reps = ((REPEAT_MASK >> p) & 1) ? 2 : 1;
            for (int r = 0; r < reps; ++r) { if (p == 5 && r > 0) (void)hipMemsetAsync((char*)d_ws + WS_CTL + CW_GCOUNT * 4, 0, 256, stream);
                a.ph_lo = p; a.ph_hi = p + 1; hipLaunchKernelGGL(fwd_kernel, dim3(grid), dim3(NTHR), LDS_BYTES, stream, a); } }
    }
}
```

```cpp
#include <hip/hip_runtime.h>
#include <cstdio>
#include <cstdint>

#ifndef MK_N_LAUNCHES
#define MK_N_LAUNCHES 1
#endif
#ifndef REPEAT_MASK
#define REPEAT_MASK 0
#endif

#define GAS __attribute__((address_space(1)))
#define LAS __attribute__((address_space(3)))
typedef unsigned short bf16_t;
typedef short bf16x8 __attribute__((ext_vector_type(8)));
typedef float f32x4 __attribute__((ext_vector_type(4)));
typedef float f32x2 __attribute__((ext_vector_type(2)));
typedef unsigned u32x4 __attribute__((ext_vector_type(4)));
typedef unsigned u32x2 __attribute__((ext_vector_type(2)));

constexpr int T = 32768, D = 2048, NB_ = 16, SEQ = 2048, NE = 64, FE = 512, NPROJ = 5120, TOPK = 8;
constexpr int DA = 1024;
constexpr float EPS = 1e-6f;
constexpr int NWAVES = 8, NTHR = 512;
constexpr int MAXBLK = 1215;

constexpr size_t MiB = 1u << 20;
constexpr size_t WS_CTL = 0, CTL_ZERO_BYTES = 1 * MiB;
constexpr size_t WS_MOD = 1 * MiB;
constexpr size_t WS_SSQ = 2 * MiB;
constexpr size_t WS_TOKE = 6 * MiB;
constexpr size_t WS_TOKR = 7 * MiB;
constexpr size_t WS_TOKW = 8 * MiB;
constexpr size_t WS_INVT = 9 * MiB;
constexpr size_t WS_WRT = 18 * MiB;
constexpr size_t WS_W2T = 32 * MiB;
constexpr size_t WS_ACT = 162 * MiB;
constexpr size_t WS_X2 = 320 * MiB;
constexpr size_t WS_UBG = 162 * MiB;
constexpr size_t WS_Y = 466 * MiB;
constexpr size_t WS_W1T = 466 * MiB;
constexpr size_t WS_WINT = 726 * MiB;
constexpr size_t WS_WOUTT = 746 * MiB;
constexpr size_t WS_H2 = 754 * MiB;
constexpr size_t WS_H = 882 * MiB;
constexpr size_t WS_END = 1074 * MiB;
static_assert(WS_Y + (size_t)MAXBLK * 256 * 2048 <= WS_END, "ws map");
static_assert(WS_ACT + (size_t)MAXBLK * 256 * 512 * 2 <= WS_Y, "ws map");
constexpr int CW_BAR = 4096;
constexpr int CW_GCOUNT = 8192;

constexpr int RING_BYTES = 131072;
constexpr int TBL_OFF = RING_BYTES;
constexpr int TBL_BLKE = TBL_OFF, TBL_BSTART = TBL_OFF + 1280, TBL_CNT = TBL_BSTART + 66 * 4 + 8;
constexpr int MISC_OFF = RING_BYTES + 4096;
constexpr int GATH_OFF = RING_BYTES + 4096 + 256;
constexpr int LDS_BYTES = 147456;
static_assert(GATH_OFF + 8192 <= LDS_BYTES, "LDS map");
static_assert(TBL_CNT + 64 * 4 <= MISC_OFF && MISC_OFF + 128 <= LDS_BYTES, "LDS map");

__device__ __forceinline__ unsigned f2bf(float f) { unsigned u = __builtin_bit_cast(unsigned, f); return (u + 0x7fffu + ((u >> 16) & 1u)) >> 16; }
__device__ __forceinline__ float bflo(unsigned w) { return __uint_as_float(w << 16); }
__device__ __forceinline__ float bfhi(unsigned w) { return __uint_as_float(w & 0xffff0000u); }
template <int CTRL> __device__ __forceinline__ float dpp_mov(float v) { return __builtin_bit_cast(float, __builtin_amdgcn_update_dpp(0, __builtin_bit_cast(int, v), CTRL, 0xF, 0xF, true)); }
__device__ __forceinline__ float row_sum16(float v) {
    v += dpp_mov<0xB1>(v); v += dpp_mov<0x4E>(v); v += dpp_mov<0x141>(v); v += dpp_mov<0x140>(v); return v; }
__device__ __forceinline__ float rdlane(float v, int l) { return __builtin_bit_cast(float, __builtin_amdgcn_readlane(__builtin_bit_cast(int, v), l)); }
__device__ __forceinline__ float wave_sum(float v) { v = row_sum16(v); return (rdlane(v, 0) + rdlane(v, 16)) + (rdlane(v, 32) + rdlane(v, 48)); }
__device__ __forceinline__ float fast_sigmoid(float x) { return __builtin_amdgcn_rcpf(1.0f + __builtin_amdgcn_exp2f(-1.44269504089f * x)); }
constexpr float SC_H = 16.0f, SC_WI = 512.0f;
constexpr float SC_YM = 16.0f, SC_WO = 512.0f;
constexpr float SC_H2 = 16.0f, SC_W1 = 512.0f, SC_ACT = 8.0f, SC_W2 = 4.0f, SC_Y = SC_ACT * SC_W2;
__device__ __forceinline__ float clamp448(float v) { return __builtin_amdgcn_fmed3f(v, -448.0f, 448.0f); }
__device__ __forceinline__ unsigned pk4_fp8(float a, float b, float c, float d) {
    int r = __builtin_amdgcn_cvt_pk_fp8_f32(clamp448(a), clamp448(b), 0, false);
    r = __builtin_amdgcn_cvt_pk_fp8_f32(clamp448(c), clamp448(d), r, true);
    return (unsigned)r;
}
typedef int i32x8 __attribute__((ext_vector_type(8)));
typedef int i32x4v __attribute__((ext_vector_type(4)));
__device__ __forceinline__ unsigned cvt_pk_bf16(float lo, float hi) { unsigned r; asm volatile("v_cvt_pk_bf16_f32 %0, %1, %2" : "=v"(r) : "v"(lo), "v"(hi)); return r; }
__device__ __forceinline__ unsigned pk2(float lo, float hi) { unsigned r; asm("v_cvt_pk_bf16_f32 %0, %1, %2" : "=v"(r) : "v"(lo), "v"(hi)); return r; }
__device__ __forceinline__ float rsq(float x) { return __builtin_amdgcn_rsqf(x); }

#define XB_TMO      128
#define XB_XCNT(j)  (256  + 64 * (j))
#define XB_XSUB(j)  (1280 + 64 * (j))
#define XB_XGEN(j)  (2304 + 64 * (j))
#define XB_TOP      3328
#define XB_TOPGEN   3392
#define XCD_BAR_WORDS 3456
#define XB_SPIN_CAP (1u << 18)
__device__ __forceinline__ unsigned xb_ld(unsigned* p)              { return __hip_atomic_load(p, __ATOMIC_RELAXED, __HIP_MEMORY_SCOPE_AGENT); }
__device__ __forceinline__ unsigned xb_add(unsigned* p, unsigned v) { return __hip_atomic_fetch_add(p, v, __ATOMIC_RELAXED, __HIP_MEMORY_SCOPE_AGENT); }
__device__ __forceinline__ unsigned xb_xcc_id() { return (unsigned)__builtin_amdgcn_s_getreg((3 << 11) | 20) & 0xFu; }
#define XB_SPIN(cond, bar) do { unsigned _sp = 0; while (cond) { __builtin_amdgcn_s_sleep(1); \
    if ((++_sp & 255u) == 0u) { if (xb_ld(&(bar)[XB_TMO])) break; if (_sp > XB_SPIN_CAP) { atomicAdd(&(bar)[XB_TMO], 1u); break; } } } } while (0)
struct XcdBarrier { unsigned* bar; unsigned x; volatile LAS unsigned* st; };
__device__ __forceinline__ XcdBarrier xcd_barrier_post(unsigned* bar, volatile LAS unsigned* st) {
    XcdBarrier b; b.bar = bar; b.x = xb_xcc_id(); b.st = st;
    if (threadIdx.x == 0) (void)xb_add(&bar[XB_XCNT(b.x)], 1u);
    return b;
}
__device__ __forceinline__ void xcd_barrier_complete(unsigned* bar, unsigned x, unsigned& nloc, unsigned& nx) {
    const unsigned G = gridDim.x * gridDim.y * gridDim.z;
    unsigned sum, cnt, mine, sp = 0u;
    for (;;) {
        sum = 0u; cnt = 0u; mine = 0u;
#pragma unroll
        for (unsigned j = 0; j < 16; ++j) { const unsigned c = xb_ld(&bar[XB_XCNT(j)]); sum += c; cnt += (c > 0u) ? 1u : 0u; mine = (j == x) ? c : mine; }
        if (sum == G) break;
        __builtin_amdgcn_s_sleep(1);
        if ((++sp & 255u) == 0u) { if (xb_ld(&bar[XB_TMO])) break; if (sp > XB_SPIN_CAP) { atomicAdd(&bar[XB_TMO], 1u); break; } }
    }
    nloc = mine > 0u ? mine : 1u; nx = cnt > 0u ? cnt : 1u;
}
__device__ __forceinline__ void xcd_barrier(const XcdBarrier& b) {
    asm volatile("s_waitcnt vmcnt(0)" ::: "memory");
    __syncthreads();
    if (threadIdx.x == 0) {
        unsigned* bar = b.bar;
        __builtin_amdgcn_s_waitcnt(0);
        unsigned nloc = b.st[0], nx = b.st[1];
        if (nloc == 0u) { xcd_barrier_complete(bar, b.x, nloc, nx); b.st[0] = nloc; b.st[1] = nx; }
        const unsigned old = xb_add(&bar[XB_XSUB(b.x)], 1u);
        const unsigned gen = old / nloc;
        if (old + 1u == (gen + 1u) * nloc) {
            __builtin_amdgcn_fence(__ATOMIC_RELEASE, "agent");
            asm volatile("s_waitcnt vmcnt(0)" ::: "memory");
            const unsigned og = xb_add(&bar[XB_TOP], 1u);
            const unsigned tg = og / nx;
            if (og + 1u == (tg + 1u) * nx) xb_add(&bar[XB_TOPGEN], 1u);
            else XB_SPIN(xb_ld(&bar[XB_TOPGEN]) == tg, bar);
            __builtin_amdgcn_fence(__ATOMIC_ACQUIRE, "agent");
            xb_add(&bar[XB_XGEN(b.x)], 1u);
            asm volatile("s_waitcnt vmcnt(0)" ::: "memory");
        } else {
            XB_SPIN(xb_ld(&bar[XB_XGEN(b.x)]) == gen, bar);
            __builtin_amdgcn_fence(__ATOMIC_ACQUIRE, "agent");
            asm volatile("s_waitcnt vmcnt(0)" ::: "memory");
        }
    }
    __syncthreads();
}

namespace pg8 {
constexpr int BM = 256, BK = 64, HALF = 128, HTB = HALF * BK * 2, STAGE_BYTES = 8 * HTB;
__host__ __device__ __forceinline__ int lds_byte(int r, int c) { const int st = (r >> 4) * 2 + (c >> 5), rr = r & 15, cc = c & 31, ob = rr * 64 + cc * 2; return st * 1024 + (ob ^ (((ob >> 9) & 1) << 5)); }
__host__ __device__ __forceinline__ void stage_rc(int b, int& R, int& C) { const int st = b / 1024, sb = b % 1024, swz = sb ^ (((sb >> 9) & 1) << 5); R = (st >> 1) * 16 + swz / 64; C = (st & 1) * 32 + (swz % 64) / 2; }
__host__ __device__ __forceinline__ int perm32(int rho) { const int n = rho >> 4, i = rho & 15; return 8 * (i >> 2) + 4 * n + (i & 3); }

struct Unit { int pm, pn, e; };

struct DenseOrder {
    static constexpr bool GATHER = false;
    int nM, nN, nwg, G, c, KB; const void* Bt;
    __device__ void init(int M, int N, int KB_, int G_, int c_, const void* Bt_) { nM = M / BM; nN = N / BM; nwg = nM * nN; G = G_; c = c_; KB = KB_; Bt = Bt_; }
    __device__ __forceinline__ bool next(int i, Unit& u) const {
        const long L = (long)i * G + c; if (L >= nwg) return false;
        int wgid = (int)L; { const int q = nwg / 8, r = nwg % 8, xcd = wgid % 8, off = wgid / 8; wgid = (xcd < r ? xcd * (q + 1) : r * (q + 1) + (xcd - r) * q) + off; }
        const int nig = 8 * nN, gid = wgid / nig, fm = gid * 8, gsz = (nM - fm) < 8 ? (nM - fm) : 8;
        u.pm = fm + ((wgid % nig) % gsz); u.pn = (wgid % nig) / gsz; u.e = 0; return true;
    }
    __device__ __forceinline__ unsigned b_off(const Unit& u) const { return (unsigned)u.pn * (256u * (unsigned)KB); }
    __device__ __forceinline__ unsigned a_unit_off(const Unit& u) const { return (unsigned)u.pm * (256u * (unsigned)KB); }
    __device__ __forceinline__ void prefetch_rows(const Unit&, LAS unsigned char*, int, int, int) const {}
    __device__ __forceinline__ void fetch_rows(const Unit&, LAS unsigned char*, int, int, int, int, unsigned (&)[2][2]) const {}
};
struct DenseOrderG : DenseOrder {
    static constexpr bool GATHER = true;
    __device__ __forceinline__ unsigned a_unit_off(const Unit&) const { return 0u; }
    __device__ __forceinline__ void fetch_rows(const Unit& u, LAS unsigned char*, int, int, int R0, int C0, unsigned (&v)[2][2]) const {
#pragma unroll
        for (int h = 0; h < 2; ++h)
#pragma unroll
            for (int i = 0; i < 2; ++i) v[h][i] = (unsigned)(u.pm * 256 + 128 * h + R0 + 64 * i) * (unsigned)KB + 2u * C0;
    }
};
template <int MODE, int NPN> struct MoeOrder {
    static constexpr bool GATHER = true;
    const LAS unsigned char* blk_e; const LAS int* blkstart; const LAS int* cnt;
    int NB, G, vcu, KB; const void* Bt; unsigned estride, boff0; const int* inv_tok;
    __device__ __forceinline__ bool next(int i, Unit& u) const {
        const int L = i * G + vcu, grp = L / (8 * NPN), w = L % (8 * NPN), rb = grp * 8 + (w & 7);
        if (rb >= NB) return false;
        u.pm = rb; u.pn = w >> 3; u.e = __builtin_amdgcn_readfirstlane((int)blk_e[rb]); return true;
    }
    __device__ __forceinline__ unsigned b_off(const Unit& u) const { return (unsigned)u.e * estride + boff0 + (unsigned)u.pn * (256u * (unsigned)KB); }
    __device__ __forceinline__ unsigned a_unit_off(const Unit& u) const { return 0u; }
    __device__ __forceinline__ void prefetch_rows(const Unit& u, LAS unsigned char* slots, int wid, int lane, int R0) const {
        if (MODE == 0) {
            const int lb = u.pm - __builtin_amdgcn_readfirstlane(blkstart[u.e]);
            const int n = (u.e < NE) ? __builtin_amdgcn_readfirstlane(cnt[u.e]) : T;
            const int* src = inv_tok + (size_t)u.e * T;
#pragma unroll
            for (int h = 0; h < 2; ++h)
#pragma unroll
                for (int i = 0; i < 2; ++i) { int rank = lb * 256 + 128 * h + R0 + 64 * i; rank = rank < n ? rank : n - 1;
                    __builtin_amdgcn_global_load_lds((const unsigned*)(src + rank), (LAS unsigned*)(slots + wid * 1024 + (h * 2 + i) * 256), 4, 0, 0); }
        }
    }
    __device__ __forceinline__ void fetch_rows(const Unit& u, LAS unsigned char* slots, int wid, int lane, int R0, int C0, unsigned (&v)[2][2]) const {
#pragma unroll
        for (int h = 0; h < 2; ++h)
#pragma unroll
            for (int i = 0; i < 2; ++i) {
                int row;
                if (MODE == 0) row = ((const LAS int*)(slots + wid * 1024 + (h * 2 + i) * 256))[lane]; else row = u.pm * 256 + 128 * h + R0 + 64 * i;
                v[h][i] = (unsigned)row * (unsigned)KB + 2u * C0; }
    }
};


struct EpiProj {
    static constexpr int BHALF_ROWS = 128;
    static __device__ __forceinline__ int brow(int R) { return (R & ~31) + perm32(R & 31); }
    bf16_t* U; bf16_t* BA; bf16_t* GLU;
    __device__ __forceinline__ void operator()(const f32x4 (&acc)[2][2][4][2], const Unit& u, int wr, int wc, int fr, int fq) const {
        const int row0 = u.pm * BM + wr * 64 + fr, pn = u.pn;
        if (pn >= 8 && pn < 12) {
            const int col0 = 256 * (pn - 8) + wc * 32 + 8 * fq;
#pragma unroll
            for (int ai = 0; ai < 2; ++ai)
#pragma unroll
                for (int m = 0; m < 4; ++m) { bf16_t* rowp = BA + (size_t)(row0 + ai * HALF + m * 16) * DA + col0;
#pragma unroll
                    for (int bj = 0; bj < 2; ++bj) { constexpr float sp = 1.0f / (SC_H * SC_WI); const f32x4 v0 = acc[ai][bj][m][0] * sp, v1 = acc[ai][bj][m][1] * sp;
                        u32x4 w; w.x = cvt_pk_bf16(v0[0], v0[1]); w.y = cvt_pk_bf16(v0[2], v0[3]); w.z = cvt_pk_bf16(v1[0], v1[1]); w.w = cvt_pk_bf16(v1[2], v1[3]);
                        *(u32x4*)(rowp + bj * HALF) = w; } }
        } else {
            const bool isu = pn < 8; bf16_t* base = isu ? U : GLU; const int col0 = 128 * (isu ? pn : pn - 12) + wc * 32 + 8 * fq;
#pragma unroll
            for (int ai = 0; ai < 2; ++ai)
#pragma unroll
                for (int m = 0; m < 4; ++m) { bf16_t* rowp = base + (size_t)(row0 + ai * HALF + m * 16) * DA + col0;
                    constexpr float sp = 1.0f / (SC_H * SC_WI);
                    f32x4 a0 = acc[ai][0][m][0] * sp, a1 = acc[ai][0][m][1] * sp; const f32x4 b0 = acc[ai][1][m][0] * sp, b1 = acc[ai][1][m][1] * sp;
                    if (isu) { a0 = a0 * b0; a1 = a1 * b1; }
                    else {
#pragma unroll
                        for (int j = 0; j < 4; ++j) { a0[j] = a0[j] * fast_sigmoid(b0[j]); a1[j] = a1[j] * fast_sigmoid(b1[j]); } }
                    u32x4 w; w.x = cvt_pk_bf16(a0[0], a0[1]); w.y = cvt_pk_bf16(a0[2], a0[3]); w.z = cvt_pk_bf16(a1[0], a1[1]); w.w = cvt_pk_bf16(a1[2], a1[3]);
                    *(u32x4*)rowp = w; }
        }
    }
};
struct EpiOut {
    static constexpr int BHALF_ROWS = 128;
    static __device__ __forceinline__ int brow(int R) { return (R & ~31) + perm32(R & 31); }
    const float* x; const float* mod; bf16_t* x2; float* ssq;
    __device__ __forceinline__ void operator()(const f32x4 (&acc)[2][2][4][2], const Unit& u, int wr, int wc, int fr, int fq) const {
        const int row0 = u.pm * BM + wr * 64 + fr, col0 = u.pn * BM + wc * 32 + 8 * fq;
        const float* gm = mod + (size_t)(u.pm >> 3) * (6 * D) + 2 * D;
        f32x4 gv[2][2];
#pragma unroll
        for (int bj = 0; bj < 2; ++bj)
#pragma unroll
            for (int n = 0; n < 2; ++n) gv[bj][n] = *(const f32x4*)(gm + col0 + bj * HALF + 4 * n);
#pragma unroll
        for (int ai = 0; ai < 2; ++ai)
#pragma unroll
          for (int mp = 0; mp < 2; ++mp) {
            f32x4 xv[2][2][2];
#pragma unroll
            for (int mm = 0; mm < 2; ++mm)
#pragma unroll
                for (int bj = 0; bj < 2; ++bj)
#pragma unroll
                    for (int n = 0; n < 2; ++n) xv[mm][bj][n] = *(const f32x4*)(x + (size_t)(row0 + ai * HALF + (2 * mp + mm) * 16) * D + col0 + bj * HALF + 4 * n);
            asm volatile("" ::: "memory");
#pragma unroll
            for (int mm = 0; mm < 2; ++mm) { const int m = 2 * mp + mm; const int row = row0 + ai * HALF + m * 16; const size_t off = (size_t)row * D + col0; float s = 0.f;
#pragma unroll
                for (int bj = 0; bj < 2; ++bj) { constexpr float so = 1.0f / (SC_YM * SC_WO); const f32x4 o0 = xv[mm][bj][0] + gv[bj][0] * (acc[ai][bj][m][0] * so), o1 = xv[mm][bj][1] + gv[bj][1] * (acc[ai][bj][m][1] * so);
                    u32x4 w; w.x = pk2(o0[0], o0[1]); w.y = pk2(o0[2], o0[3]); w.z = pk2(o1[0], o1[1]); w.w = pk2(o1[2], o1[3]);
                    *(u32x4*)(x2 + off + bj * HALF) = w;
                    const float r0 = bflo(w.x), r1 = bfhi(w.x), r2 = bflo(w.y), r3 = bfhi(w.y), r4 = bflo(w.z), r5 = bfhi(w.z), r6 = bflo(w.w), r7 = bfhi(w.w);
                    s += ((r0 * r0 + r1 * r1) + (r2 * r2 + r3 * r3)) + ((r4 * r4 + r5 * r5) + (r6 * r6 + r7 * r7)); }
                s += __shfl_xor(s, 16); s += __shfl_xor(s, 32);
                if (fq == 0) ssq[(size_t)(u.pn * 4 + wc) * T + row] = s; }
            asm volatile("" ::: "memory");
          }
    }
};
struct EpiAct {
    static constexpr int BHALF_ROWS = 128;
    static __device__ __forceinline__ int brow(int R) { return (R & ~31) + perm32(R & 31); }
    unsigned char* act;
    __device__ __forceinline__ void operator()(const f32x4 (&acc)[2][2][4][2], const Unit& u, int wr, int wc, int fr, int fq) const {
        const int row0 = u.pm * BM + wr * 64 + fr, col0 = 128 * u.pn + wc * 32 + 8 * fq;
#pragma unroll
        for (int ai = 0; ai < 2; ++ai)
#pragma unroll
            for (int m = 0; m < 4; ++m) { unsigned char* rowp = act + (size_t)(row0 + ai * HALF + m * 16) * FE + col0;
                constexpr float s1 = 1.0f / (SC_H2 * SC_W1), s2 = SC_ACT / (SC_H2 * SC_W1);
                f32x4 a0 = acc[ai][0][m][0] * s1, a1 = acc[ai][0][m][1] * s1; const f32x4 b0 = acc[ai][1][m][0] * s2, b1 = acc[ai][1][m][1] * s2;
#pragma unroll
                for (int j = 0; j < 4; ++j) { a0[j] = a0[j] * fast_sigmoid(a0[j]) * b0[j]; a1[j] = a1[j] * fast_sigmoid(a1[j]) * b1[j]; }
                u32x2 w; w.x = pk4_fp8(a0[0], a0[1], a0[2], a0[3]); w.y = pk4_fp8(a1[0], a1[1], a1[2], a1[3]);
                *(u32x2*)rowp = w; }
    }
};
struct EpiY8 {
    static constexpr int BHALF_ROWS = 8;
    static __device__ __forceinline__ int brow(int R) { return 64 * (R >> 5) + 16 * ((R & 15) >> 2) + 4 * ((R >> 4) & 1) + (R & 3); }
    unsigned char* Y;
    __device__ __forceinline__ void operator()(const f32x4 (&acc)[2][2][4][2], const Unit& u, int wr, int wc, int fr, int fq) const {
        const int row0 = u.pm * BM + wr * 64 + fr, col0 = u.pn * BM + 64 * wc + 16 * fq;
        static_assert(SC_Y == SC_ACT * SC_W2, "y rows are stored unscaled");
#pragma unroll
        for (int ai = 0; ai < 2; ++ai)
#pragma unroll
            for (int m = 0; m < 4; ++m) { unsigned char* rowp = Y + (size_t)(row0 + ai * HALF + m * 16) * D + col0;
                const f32x4 v0 = acc[ai][0][m][0], v1 = acc[ai][0][m][1], v2 = acc[ai][1][m][0], v3 = acc[ai][1][m][1];
                u32x4 w; w.x = pk4_fp8(v0[0], v0[1], v0[2], v0[3]); w.y = pk4_fp8(v1[0], v1[1], v1[2], v1[3]); w.z = pk4_fp8(v2[0], v2[1], v2[2], v2[3]); w.w = pk4_fp8(v3[0], v3[1], v3[2], v3[3]);
                __builtin_nontemporal_store(w, (u32x4*)rowp); }
    }
};

template <bool FP8, class Epi, class Sched>
__device__ __forceinline__ void gemm_phase(LAS unsigned char* lds, const void* A, unsigned abytes, const void* Bt, unsigned bbytes, const int KB_, const Sched& S, const Epi& E) {
    int KB = KB_; asm volatile("" : "+s"(KB));
    const int tid = threadIdx.x, wid = __builtin_amdgcn_readfirstlane(tid >> 6), lane = tid & 63, wr = wid >> 2, wc = wid & 3, fr = lane & 15, fq = lane >> 4;
    const int nt = KB / 128;
    int R0, C0; stage_rc(tid * 16, R0, C0);
    unsigned voffB[2], vd[2];
#pragma unroll
    for (int i = 0; i < 2; ++i) { const int R = R0 + 64 * i; const int Rb = Epi::brow(R); voffB[i] = (unsigned)Rb * (unsigned)KB + 2u * C0; vd[i] = (unsigned)R * (unsigned)KB + 2u * C0; }
    constexpr bool GA = Sched::GATHER;
    LAS unsigned char* slots = lds + GATH_OFF;
    const __amdgpu_buffer_rsrc_t rsA = __builtin_amdgcn_make_buffer_rsrc((void*)A, 0, (int)abytes, 0x00020000);
    const __amdgpu_buffer_rsrc_t rsB = __builtin_amdgcn_make_buffer_rsrc((void*)Bt, 0, (int)bbytes, 0x00020000);
    const unsigned kstep = 128u;
    const unsigned hstep = (unsigned)HALF * (unsigned)KB;
    const unsigned hstepB = (unsigned)Epi::BHALF_ROWS * (unsigned)KB;
    const unsigned ldsw = (unsigned)wid * 1024u;
    const int aoff = lds_byte(wr * 64 + fr, fq * 8), boff = lds_byte(wc * 32 + fr, fq * 8);
#define PG8_SA(b, h) (((b) * 2 + (h)) * HTB)
#define PG8_SB(b, h) ((4 + (b) * 2 + (h)) * HTB)
#define PG8_STAGE(bufoff, rs, soff, voff) do { _Pragma("unroll") for (int _i = 0; _i < 2; ++_i) \
        __builtin_amdgcn_raw_ptr_buffer_load_lds(rs, (LAS void*)(lds + (bufoff) + ldsw + _i * 8192), 16, (int)(voff)[_i], (int)(soff), 0, 0); } while (0)
#define PG8_STAGE_A(bufoff, so, h) do { if constexpr (GA) PG8_STAGE(bufoff, rsA, so, vc[h]); else PG8_STAGE(bufoff, rsA, (so) + (h) * hstep, vd); } while (0)
#define PG8_LDA(dst, b, h) do { _Pragma("unroll") for (int m = 0; m < 4; ++m) { \
        if constexpr (FP8) { const i32x4v _lo = *(const LAS i32x4v*)(lds + PG8_SA(b, h) + aoff + m * 2048), _hi = *(const LAS i32x4v*)(lds + PG8_SA(b, h) + aoff + m * 2048 + 1024); \
            dst##8[m] = __builtin_shufflevector(_lo, _hi, 0, 1, 2, 3, 4, 5, 6, 7); } \
        else { _Pragma("unroll") for (int k = 0; k < 2; ++k) dst[m][k] = *(const LAS bf16x8*)(lds + PG8_SA(b, h) + aoff + m * 2048 + k * 1024); } } } while (0)
#define PG8_LDB(dst, b, h) do { _Pragma("unroll") for (int n = 0; n < 2; ++n) { \
        if constexpr (FP8) { const i32x4v _lo = *(const LAS i32x4v*)(lds + PG8_SB(b, h) + boff + n * 2048), _hi = *(const LAS i32x4v*)(lds + PG8_SB(b, h) + boff + n * 2048 + 1024); \
            dst##8[n] = __builtin_shufflevector(_lo, _hi, 0, 1, 2, 3, 4, 5, 6, 7); } \
        else { _Pragma("unroll") for (int k = 0; k < 2; ++k) dst[n][k] = *(const LAS bf16x8*)(lds + PG8_SB(b, h) + boff + n * 2048 + k * 1024); } } } while (0)
#define PG8_MMA(ai, bj, At, Bt) do { __builtin_amdgcn_s_setprio(1); _Pragma("unroll") for (int m = 0; m < 4; ++m) _Pragma("unroll") for (int n = 0; n < 2; ++n) { \
        if constexpr (FP8) { acc[ai][bj][m][n] = __builtin_amdgcn_mfma_scale_f32_16x16x128_f8f6f4(Bt##8[n], At##8[m], acc[ai][bj][m][n], 0, 0, 0, 0x7F7F7F7F, 0, 0x7F7F7F7F); } \
        else { _Pragma("unroll") for (int k = 0; k < 2; ++k) acc[ai][bj][m][n] = __builtin_amdgcn_mfma_f32_16x16x32_bf16(Bt[n][k], At[m][k], acc[ai][bj][m][n], 0, 0, 0); } } \
        __builtin_amdgcn_s_setprio(0); } while (0)
#define PG8_WAIT_V(n) asm volatile("s_waitcnt vmcnt(" #n ")" ::: "memory")
#define PG8_WAIT_L(n) asm volatile("s_waitcnt lgkmcnt(" #n ")" ::: "memory")
#define PG8_BAR __builtin_amdgcn_s_barrier()
#define PG8_SCHED __builtin_amdgcn_sched_barrier(0)
    Unit cur, nxt; int ui = 0;
    if (!S.next(0, cur)) return;
    f32x4 acc[2][2][4][2];
#pragma unroll
    for (int a = 0; a < 2; ++a)
#pragma unroll
        for (int b = 0; b < 2; ++b)
#pragma unroll
            for (int m = 0; m < 4; ++m)
#pragma unroll
                for (int n = 0; n < 2; ++n) acc[a][b][m][n] = (f32x4){0.f, 0.f, 0.f, 0.f};
    bf16x8 At[4][2], B0[2][2], B1[2][2];
    i32x8 At8[4], B08[2], B18[2];
    unsigned cA = S.a_unit_off(cur), cB = S.b_off(cur);
    unsigned vc[2][2] = {{0u, 0u}, {0u, 0u}};
    if constexpr (GA) { S.prefetch_rows(cur, slots, wid, lane, R0); PG8_WAIT_V(0); S.fetch_rows(cur, slots, wid, lane, R0, C0, vc); PG8_WAIT_L(0); }
    PG8_STAGE(PG8_SB(0, 0), rsB, cB, voffB); PG8_STAGE(PG8_SB(0, 1), rsB, cB + hstepB, voffB); PG8_STAGE_A(PG8_SA(0, 0), cA, 0); PG8_STAGE_A(PG8_SA(0, 1), cA, 1);
    if (wr == 1) PG8_BAR;
    PG8_WAIT_V(2); PG8_BAR;
    PG8_STAGE(PG8_SB(1, 0), rsB, cB + kstep, voffB); PG8_STAGE_A(PG8_SA(1, 0), cA + kstep, 0); PG8_STAGE(PG8_SB(1, 1), rsB, cB + hstepB + kstep, voffB);
    PG8_WAIT_V(6); PG8_BAR;
    for (;;) {
        const bool has_next = S.next(ui + 1, nxt);
        unsigned nB = cB, nA = cA;
        if (has_next) { nB = S.b_off(nxt); nA = S.a_unit_off(nxt); if constexpr (GA) S.prefetch_rows(nxt, slots, wid, lane, R0); }
#pragma unroll 1
        for (int t = 0; t < nt; t += 2) {
            const bool last = (t == nt - 2);
            const unsigned a1 = cA + (unsigned)(t + 1) * kstep;
            const unsigned a2 = last ? nA : cA + (unsigned)(t + 2) * kstep, b2 = last ? nB : cB + (unsigned)(t + 2) * kstep;
            const unsigned a3 = a2 + kstep, b3 = b2 + kstep;
            PG8_LDB(B0, 0, 0); PG8_LDB(B1, 0, 1); PG8_SCHED; PG8_LDA(At, 0, 0); PG8_STAGE_A(PG8_SA(1, 1), a1, 1);
            if constexpr (GA) { if (last && has_next) S.fetch_rows(nxt, slots, wid, lane, R0, C0, vc); }
            PG8_WAIT_V(8); PG8_WAIT_L(0); PG8_BAR; PG8_MMA(0, 0, At, B0); PG8_MMA(0, 1, At, B1); PG8_BAR; PG8_SCHED;
            PG8_LDA(At, 0, 1); PG8_STAGE(PG8_SB(0, 0), rsB, b2, voffB); PG8_STAGE(PG8_SB(0, 1), rsB, b2 + hstepB, voffB); PG8_STAGE_A(PG8_SA(0, 0), a2, 0);
            PG8_WAIT_V(8); PG8_WAIT_L(0); PG8_BAR; PG8_MMA(1, 0, At, B0); PG8_MMA(1, 1, At, B1); PG8_BAR; PG8_SCHED;
            PG8_LDB(B0, 1, 0); PG8_LDB(B1, 1, 1); PG8_SCHED; PG8_LDA(At, 1, 0); PG8_STAGE_A(PG8_SA(0, 1), a2, 1);
            PG8_WAIT_V(8); PG8_WAIT_L(0); PG8_BAR; PG8_MMA(0, 0, At, B0); PG8_MMA(0, 1, At, B1); PG8_BAR; PG8_SCHED;
            PG8_LDA(At, 1, 1); PG8_STAGE(PG8_SB(1, 0), rsB, b3, voffB); PG8_STAGE(PG8_SB(1, 1), rsB, b3 + hstepB, voffB); PG8_STAGE_A(PG8_SA(1, 0), a3, 0);
            PG8_WAIT_V(8); PG8_WAIT_L(0); PG8_BAR; PG8_MMA(1, 0, At, B0); PG8_MMA(1, 1, At, B1); PG8_BAR; PG8_SCHED;
        }
        if (wr == 0) PG8_BAR;
        E(acc, cur, wr, wc, fr, fq);
        if (!has_next) break;
#pragma unroll
        for (int a = 0; a < 2; ++a)
#pragma unroll
            for (int b = 0; b < 2; ++b)
#pragma unroll
                for (int m = 0; m < 4; ++m)
#pragma unroll
                    for (int n = 0; n < 2; ++n) acc[a][b][m][n] = (f32x4){0.f, 0.f, 0.f, 0.f};
        cur = nxt; cB = nB; cA = nA; ++ui;
        if (wr == 1) PG8_BAR;
    }
    PG8_WAIT_V(0);
    PG8_BAR;
#undef PG8_SA
#undef PG8_SB
#undef PG8_STAGE
#undef PG8_STAGE_A
#undef PG8_LDA
#undef PG8_LDB
#undef PG8_MMA
#undef PG8_WAIT_V
#undef PG8_WAIT_L
#undef PG8_BAR
#undef PG8_SCHED
}
}

struct Args { const float* in[24]; float* out; unsigned char* ws; int ph_lo, ph_hi; };

__device__ __forceinline__ void p0_transpose_item(const float* W, int K, int N, bf16_t* WT, int k0, int n0, int rowbase, LAS float* scr, int lane) {
#pragma unroll 8
    for (int i = 0; i < 32; ++i) { const int kk = 2 * i + (lane >> 5); scr[kk * 33 + (lane & 31)] = W[(size_t)(k0 + kk) * N + n0 + (lane & 31)]; }
    asm volatile("s_waitcnt lgkmcnt(0)" ::: "memory");
    const int c = lane & 7;
#pragma unroll
    for (int j = 0; j < 4; ++j) { const int n = (lane >> 3) + 8 * j; const LAS float* s = scr + (8 * c) * 33 + n;
        u32x4 o; o.x = pk2(s[0 * 33], s[1 * 33]); o.y = pk2(s[2 * 33], s[3 * 33]); o.z = pk2(s[4 * 33], s[5 * 33]); o.w = pk2(s[6 * 33], s[7 * 33]);
        *(u32x4*)(WT + (size_t)(rowbase + n) * K + k0 + 8 * c) = o; }
    asm volatile("s_waitcnt lgkmcnt(0)" ::: "memory");
}
__device__ __forceinline__ void p0_transpose_item_fp8(const float* W, int K, int N, unsigned char* WT, int k0, int n0, int rowbase, float sc, LAS float* scr, int lane) {
#pragma unroll 8
    for (int i = 0; i < 64; ++i) { const int kk = 2 * i + (lane >> 5); scr[kk * 33 + (lane & 31)] = W[(size_t)(k0 + kk) * N + n0 + (lane & 31)]; }
    asm volatile("s_waitcnt lgkmcnt(0)" ::: "memory");
    const int c = lane & 7;
#pragma unroll
    for (int j = 0; j < 4; ++j) { const int n = (lane >> 3) + 8 * j; const LAS float* s = scr + (16 * c) * 33 + n;
        u32x4 o; o.x = pk4_fp8(s[0 * 33] * sc, s[1 * 33] * sc, s[2 * 33] * sc, s[3 * 33] * sc); o.y = pk4_fp8(s[4 * 33] * sc, s[5 * 33] * sc, s[6 * 33] * sc, s[7 * 33] * sc);
        o.z = pk4_fp8(s[8 * 33] * sc, s[9 * 33] * sc, s[10 * 33] * sc, s[11 * 33] * sc); o.w = pk4_fp8(s[12 * 33] * sc, s[13 * 33] * sc, s[14 * 33] * sc, s[15 * 33] * sc);
        *(u32x4*)(WT + (size_t)(rowbase + n) * K + k0 + 16 * c) = o; }
    asm volatile("s_waitcnt lgkmcnt(0)" ::: "memory");
}
__device__ __forceinline__ void p0_router_item(const float* W, bf16_t* WThi, bf16_t* WTlo, int k0, int n0, LAS float* scr, int lane) {
    constexpr int K = D, N = NE;
#pragma unroll 8
    for (int i = 0; i < 32; ++i) { const int kk = 2 * i + (lane >> 5); scr[kk * 33 + (lane & 31)] = W[(size_t)(k0 + kk) * N + n0 + (lane & 31)]; }
    asm volatile("s_waitcnt lgkmcnt(0)" ::: "memory");
    const int c = lane & 7;
#pragma unroll
    for (int j = 0; j < 4; ++j) { const int n = (lane >> 3) + 8 * j; const LAS float* s = scr + (8 * c) * 33 + n;
        unsigned hi[8], lo[8];
#pragma unroll
        for (int q = 0; q < 8; ++q) { const float v = s[q * 33]; hi[q] = f2bf(v); lo[q] = f2bf(v - __uint_as_float(hi[q] << 16)); }
        u32x4 oh, ol; oh.x = hi[0] | (hi[1] << 16); oh.y = hi[2] | (hi[3] << 16); oh.z = hi[4] | (hi[5] << 16); oh.w = hi[6] | (hi[7] << 16);
        ol.x = lo[0] | (lo[1] << 16); ol.y = lo[2] | (lo[3] << 16); ol.z = lo[4] | (lo[5] << 16); ol.w = lo[6] | (lo[7] << 16);
        *(u32x4*)(WThi + (size_t)(n0 + n) * K + k0 + 8 * c) = oh; *(u32x4*)(WTlo + (size_t)(n0 + n) * K + k0 + 8 * c) = ol; }
    asm volatile("s_waitcnt lgkmcnt(0)" ::: "memory");
}
__device__ __forceinline__ int win_rowbase(int n0) {
    if (n0 < 1024) return 256 * (n0 >> 7) + (n0 & 127);
    if (n0 < 2048) return 2048 + (n0 - 1024);
    if (n0 < 3072) { const int n = n0 - 2048; return 256 * (n >> 7) + 128 + (n & 127); }
    if (n0 < 4096) { const int n = n0 - 3072; return 3072 + 256 * (n >> 7) + (n & 127); }
    { const int n = n0 - 4096; return 3072 + 256 * (n >> 7) + 128 + (n & 127); }
}

__device__ __forceinline__ void build_tables(LAS unsigned char* lds, const unsigned* gcount, int& NBr) {
    LAS unsigned char* blk_e = lds + TBL_BLKE; LAS int* blkstart = (LAS int*)(lds + TBL_BSTART); LAS int* cnt = (LAS int*)(lds + TBL_CNT);
    const int tid = threadIdx.x;
    __syncthreads();
    if (tid < NE) cnt[tid] = (int)gcount[tid];
    __syncthreads();
    if (tid == 0) { int s = 0; for (int e = 0; e < NE; ++e) { blkstart[e] = s; s += (cnt[e] + 255) >> 8; } blkstart[NE] = s; }
    __syncthreads();
    NBr = blkstart[NE];
    if (tid < NE) { const int b0 = blkstart[tid], nb = (cnt[tid] + 255) >> 8; for (int i = 0; i < nb; ++i) blk_e[b0 + i] = (unsigned char)tid; }
    if (tid >= 64 && tid < 64 + 128) blk_e[NBr + tid - 64] = (unsigned char)NE;
    __syncthreads();
}


typedef const __attribute__((address_space(4))) Args* KArgsP;
__device__ __forceinline__ KArgsP kargs() { KArgsP p = (KArgsP)__builtin_amdgcn_kernarg_segment_ptr(); asm volatile("" : "+s"(p)); return p; }
#define WSP(type, name, off) type* name = (type*)(ws + (off))
__global__ void __launch_bounds__(NTHR, 2) fwd_kernel(Args args) {
    extern __shared__ __attribute__((aligned(16))) unsigned char lds_raw[];
    LAS unsigned char* lds = (LAS unsigned char*)lds_raw;
    volatile LAS unsigned* MISC = (volatile LAS unsigned*)(lds + MISC_OFF);
    const int tid = threadIdx.x, lane = tid & 63, wave = __builtin_amdgcn_readfirstlane(tid >> 6);
    const int G = gridDim.x, bx = blockIdx.x;
    const int vcu = (G % 8 == 0) ? (bx % 8) * (G / 8) + bx / 8 : bx;
    unsigned* ctl = (unsigned*)(args.ws + WS_CTL);
    for (int u = tid; u < (LDS_BYTES - MISC_OFF) / 4; u += NTHR) ((LAS unsigned*)(lds + MISC_OFF))[u] = 0u;
    __syncthreads();
    XcdBarrier bar; bar.bar = ctl + CW_BAR; bar.x = 0; bar.st = nullptr;
    if (MK_N_LAUNCHES == 1) bar = xcd_barrier_post(ctl + CW_BAR, MISC + 8);
    const int lo = args.ph_lo, hi = args.ph_hi;
#ifndef PH_MASK
#define PH_MASK 0x1ff
#endif
#define IN(k) ((((PH_MASK) >> (k)) & 1) && lo <= (k) && (k) < hi)
#define SEAM(k) do { if (IN(k) && IN((k) + 1)) xcd_barrier(bar); } while (0)

    if (IN(0)) {
        KArgsP ap = kargs(); unsigned char* ws = ap->ws;
        const float* cvec = ap->in[1]; const float* w_ada = ap->in[2]; const float* b_ada = ap->in[3];
        WSP(float, mod, WS_MOD);
        {
            LAS float* cs = (LAS float*)lds;
            for (int it = bx; it < 192; it += G) {
                __syncthreads();
                for (int i = tid; i < NB_ * D; i += NTHR) { const float v = cvec[i]; cs[i] = v / (1.0f + expf(-v)); }
                __syncthreads();
                const int n0 = 64 * it, cg = tid & 15, rl = tid >> 4;
                float a[16][4];
#pragma unroll
                for (int b = 0; b < 16; ++b) { a[b][0] = 0.f; a[b][1] = 0.f; a[b][2] = 0.f; a[b][3] = 0.f; }
#pragma unroll 2
                for (int kk = rl; kk < D; kk += 32) {
                    const f32x4 w4 = *(const f32x4*)(w_ada + (size_t)kk * (6 * D) + n0 + 4 * cg);
#pragma unroll
                    for (int b = 0; b < 16; ++b) { const float s = cs[b * D + kk]; a[b][0] += s * w4[0]; a[b][1] += s * w4[1]; a[b][2] += s * w4[2]; a[b][3] += s * w4[3]; }
                }
#pragma unroll
                for (int b = 0; b < 16; ++b)
#pragma unroll
                    for (int c = 0; c < 4; ++c) { float v = a[b][c]; v += __shfl_xor(v, 16); v += __shfl_xor(v, 32); a[b][c] = v; }
                __syncthreads();
                LAS float* red = (LAS float*)lds;
                if (lane < 16) {
#pragma unroll
                    for (int b = 0; b < 16; ++b)
#pragma unroll
                        for (int c = 0; c < 4; ++c) red[(wave * 16 + b) * 64 + 4 * cg + c] = a[b][c];
                }
                __syncthreads();
                for (int o = tid; o < 16 * 64; o += NTHR) { const int b = o >> 6, c = o & 63; float s = b_ada[n0 + c];
#pragma unroll
                    for (int w = 0; w < 8; ++w) s += red[(w * 16 + b) * 64 + c];
                    mod[(size_t)b * (6 * D) + n0 + c] = s; }
            }
            __syncthreads();
        }
        {
            const float* w_in = ap->in[5]; const float* w_out = ap->in[13]; const float* w_router = ap->in[15];
            const float* w_gate = ap->in[17]; const float* w_up = ap->in[18]; const float* w_down = ap->in[19];
            const float* ws_gate = ap->in[20]; const float* ws_up = ap->in[21]; const float* ws_down = ap->in[22];
            WSP(bf16_t, WrThi, WS_WRT); bf16_t* WrTlo = WrThi + (size_t)NE * D;
            WSP(unsigned char, W2T, WS_W2T); WSP(unsigned char, W1T, WS_W1T); WSP(bf16_t, WinT, WS_WINT); WSP(bf16_t, WoutT, WS_WOUTT);
            LAS float* scr = (LAS float*)(lds + wave * 16896);
            static_assert(NWAVES * 16896 <= MISC_OFF, "P0 scratch");
            const int gw = vcu * NWAVES + wave, NGW = G * NWAVES;
            constexpr int I_IN = 16 * 160, I_OUT = 16 * 64, I_GU = 16 * 16, I_DN = 4 * 64, I_RT = 32 * 2;
            constexpr int NITEMS = I_IN + I_OUT + 65 * 2 * I_GU + 65 * I_DN + I_RT;
            for (int it = gw; it < NITEMS; it += NGW) {
                int r = it;
                if (r < I_IN) { const int kb = r / 160, nb = r % 160; p0_transpose_item_fp8(w_in, D, NPROJ, (unsigned char*)WinT, 128 * kb, 32 * nb, win_rowbase(32 * nb), SC_WI, scr, lane); continue; } r -= I_IN;
                if (r < I_OUT) { const int kb = r / 64, nb = r % 64; p0_transpose_item_fp8(w_out, D, D, (unsigned char*)WoutT, 128 * kb, 32 * nb, 32 * nb, SC_WO, scr, lane); continue; } r -= I_OUT;
                if (r < 65 * 2 * I_GU) { const int e = r / (2 * I_GU), r2 = r % (2 * I_GU), isup = r2 / I_GU, r3 = r2 % I_GU, kb = r3 / 16, nb = r3 % 16, n0 = 32 * nb;
                    const float* W = (e < NE) ? ((isup ? w_up : w_gate) + (size_t)e * D * FE) : (isup ? ws_up : ws_gate);
                    p0_transpose_item_fp8(W, D, FE, W1T + (size_t)e * 1024 * D, 128 * kb, n0, 256 * (n0 >> 7) + 128 * isup + (n0 & 127), SC_W1, scr, lane); continue; } r -= 65 * 2 * I_GU;
                if (r < 65 * I_DN) { const int e = r / I_DN, r3 = r % I_DN, kb = r3 / 64, nb = r3 % 64;
                    const float* W = (e < NE) ? (w_down + (size_t)e * FE * D) : ws_down;
                    p0_transpose_item_fp8(W, FE, D, W2T + (size_t)e * D * FE, 128 * kb, 32 * nb, 32 * nb, SC_W2, scr, lane); continue; } r -= 65 * I_DN;
                { const int kb = r / 2, nb = r % 2; p0_router_item(w_router, WrThi, WrTlo, 64 * kb, 32 * nb, scr, lane); }
            }
        }
    }
    SEAM(0);

    if (IN(1)) {
        KArgsP ap = kargs(); unsigned char* ws = ap->ws;
        const float* x = ap->in[0]; const float* norm_mix_g = ap->in[4];
        WSP(float, mod, WS_MOD); WSP(bf16_t, Hb, WS_H);
        LAS float* Av = (LAS float*)lds; LAS float* Bv = Av + D;
        for (int ch = bx; ch < T / 128; ch += G) {
            const int b = ch >> 4; const float* mb = mod + (size_t)b * (6 * D);
            __syncthreads();
            for (int k = tid; k < D; k += NTHR) { Av[k] = norm_mix_g[k] * (1.0f + mb[D + k]); Bv[k] = mb[k]; }
            __syncthreads();
            for (int rr = 0; rr < 16; rr += 2) {
                const int row = ch * 128 + wave * 16 + rr;
                const f32x4* xr0 = (const f32x4*)(x + (size_t)row * D) + lane; const f32x4* xr1 = xr0 + D / 4;
                f32x4 v0[8], v1[8]; float s0 = 0.f, s1 = 0.f;
#pragma unroll
                for (int j = 0; j < 8; ++j) { v0[j] = xr0[64 * j]; v1[j] = xr1[64 * j]; }
#pragma unroll
                for (int j = 0; j < 8; ++j) { s0 += (v0[j][0] * v0[j][0] + v0[j][1] * v0[j][1]) + (v0[j][2] * v0[j][2] + v0[j][3] * v0[j][3]);
                                              s1 += (v1[j][0] * v1[j][0] + v1[j][1] * v1[j][1]) + (v1[j][2] * v1[j][2] + v1[j][3] * v1[j][3]); }
                const float rstd0 = rsq(wave_sum(s0) * (1.0f / D) + EPS), rstd1 = rsq(wave_sum(s1) * (1.0f / D) + EPS);
                unsigned* o0 = (unsigned*)((unsigned char*)Hb + (size_t)row * D) + lane; unsigned* o1 = o0 + D / 4;
#pragma unroll
                for (int j = 0; j < 8; ++j) { const f32x4 a4 = *(const LAS f32x4*)(Av + 256 * j + 4 * lane), b4 = *(const LAS f32x4*)(Bv + 256 * j + 4 * lane);
                    const f32x4 h0 = (v0[j] * rstd0 * a4 + b4) * SC_H, h1 = (v1[j] * rstd1 * a4 + b4) * SC_H;
                    o0[64 * j] = pk4_fp8(h0[0], h0[1], h0[2], h0[3]); o1[64 * j] = pk4_fp8(h1[0], h1[1], h1[2], h1[3]); }
            }
        }
        __syncthreads();
    }
    SEAM(1);

    if (IN(2)) {
        KArgsP ap = kargs(); unsigned char* ws = ap->ws;
        WSP(bf16_t, WinT, WS_WINT); WSP(bf16_t, Hb, WS_H); WSP(bf16_t, Ub, WS_UBG); bf16_t* BAb = Ub + (size_t)T * DA; bf16_t* GLUb = BAb + (size_t)T * DA;
        pg8::DenseOrderG S; S.init(T, NPROJ, D, G, bx, WinT);
        pg8::EpiProj E{Ub, BAb, GLUb};
        pg8::gemm_phase<true, pg8::EpiProj, pg8::DenseOrderG>(lds, Hb, (unsigned)T * D, WinT, (unsigned)NPROJ * D, D, S, E);
    }
    SEAM(2);

    if (IN(3)) {
        KArgsP ap = kargs(); unsigned char* ws = ap->ws;
        const float* conv_a_w = ap->in[6]; const float* conv_b_w = ap->in[7]; const float* conv_b_b = ap->in[8];
        const float* ln_b_g = ap->in[9]; const float* ln_b_b = ap->in[10]; const float* hn_a_g = ap->in[11]; const float* hn_b_g = ap->in[12];
        WSP(bf16_t, Hb, WS_H); WSP(bf16_t, Ub, WS_UBG); bf16_t* BAb = Ub + (size_t)T * DA; bf16_t* GLUb = BAb + (size_t)T * DA;
        constexpr int CT = 32, NR = CT + 30, NRW = (NR + 7) / 8;
        LAS unsigned char* gt = lds;
        LAS unsigned short* zl = (LAS unsigned short*)(lds + 65536);
        static_assert(NR * 1024 <= 65536 && 65536 + CT * 1024 * 2 <= RING_BYTES, "P3 LDS map");
        constexpr int NCH = T / CT;
        u32x4 R[NRW];
#define P3_LOAD_TILE(chunk, pass) do { const int _t0 = (chunk) * CT, _tp = _t0 & (SEQ - 1); _Pragma("unroll") for (int _i = 0; _i < NRW; ++_i) { const int _r = wave + 8 * _i; \
            R[_i] = (u32x4){0u, 0u, 0u, 0u}; if (_r < NR && _tp - 30 + _r >= 0) R[_i] = *(const u32x4*)(GLUb + (size_t)(_t0 - 30 + _r) * DA + 512 * (pass) + 8 * lane); } } while (0)
#define P3_STORE_TILE() do { _Pragma("unroll") for (int _i = 0; _i < NRW; ++_i) { const int _r = wave + 8 * _i; if (_r < NR) *(LAS u32x4*)(gt + _r * 1024 + 16 * lane) = R[_i]; } } while (0)
#define P3_LOAD_W(pass) do { _Pragma("unroll") for (int _j = 0; _j < 31; ++_j) wv[_j] = __uint_as_float(__builtin_amdgcn_raw_buffer_load_b32(rsW, (tid + 512 * (pass)) * 4, _j * DA * 4, 0)); bias = conv_b_b[tid + 512 * (pass)]; } while (0)
#define P3_CONV(pass) do { float xv[NR]; _Pragma("unroll") for (int _i = 0; _i < NR; ++_i) xv[_i] = __uint_as_float(((unsigned)*(const LAS unsigned short*)(gt + _i * 1024 + 2 * tid)) << 16); \
            float _o[CT]; _Pragma("unroll") for (int _i = 0; _i < CT; ++_i) _o[_i] = bias; \
            _Pragma("unroll") for (int _j = 0; _j < 31; ++_j) _Pragma("unroll") for (int _i = 0; _i < CT; ++_i) _o[_i] = __builtin_fmaf(wv[_j], xv[_i + _j], _o[_i]);     \
            _Pragma("unroll") for (int _i = 0; _i < CT; ++_i) zl[_i * DA + tid + 512 * (pass)] = (unsigned short)pk2(_o[_i], 0.f); } while (0)
        float wv[31], bias;
        const __amdgpu_buffer_rsrc_t rsW = __builtin_amdgcn_make_buffer_rsrc((void*)conv_b_w, 0, 31 * DA * 4, 0x00020000);
        if (bx < NCH) { P3_LOAD_TILE(bx, 0); P3_STORE_TILE(); }
        for (int ch = bx; ch < NCH; ch += G) {
            const int t0 = ch * CT, tpos = t0 & (SEQ - 1), nxt = ch + G;
            P3_LOAD_W(0);
            __syncthreads();
            P3_LOAD_TILE(ch, 1);
            P3_CONV(0);
            P3_LOAD_W(1);
            __syncthreads();
            P3_STORE_TILE();
            __syncthreads();
            if (nxt < NCH) P3_LOAD_TILE(nxt, 0);
            P3_CONV(1);
            __syncthreads();
            if (nxt < NCH) P3_STORE_TILE();
            f32x4 lng[4], lnb[4], hnb[4], hna[4], cw0[4], cw1[4], cw2[4];
#pragma unroll
            for (int j = 0; j < 4; ++j) { const int c = 256 * j + 4 * lane;
                lng[j] = *(const f32x4*)(ln_b_g + c); lnb[j] = *(const f32x4*)(ln_b_b + c); hnb[j] = *(const f32x4*)(hn_b_g + c); hna[j] = *(const f32x4*)(hn_a_g + c);
                cw0[j] = *(const f32x4*)(conv_a_w + c); cw1[j] = *(const f32x4*)(conv_a_w + DA + c); cw2[j] = *(const f32x4*)(conv_a_w + 2 * DA + c); }
#pragma unroll 2
            for (int ii = 0; ii < CT / 8; ++ii) {
                const int i = (CT / 8) * wave + ii, t = t0 + i, tp = tpos + i;
                u32x2 pu0[4], pu1[4], pu2[4], pbb[4];
#pragma unroll
                for (int j = 0; j < 4; ++j) { const int c = 256 * j + 4 * lane;
                    pu0[j] = *(const u32x2*)(Ub + (size_t)t * DA + c); pbb[j] = *(const u32x2*)(BAb + (size_t)t * DA + c);
                    pu1[j] = (u32x2){0u, 0u}; pu2[j] = (u32x2){0u, 0u};
                    if (tp >= 1) pu1[j] = *(const u32x2*)(Ub + (size_t)(t - 1) * DA + c);
                    if (tp >= 2) pu2[j] = *(const u32x2*)(Ub + (size_t)(t - 2) * DA + c); }
                f32x4 z[4]; float s = 0.f;
#pragma unroll
                for (int j = 0; j < 4; ++j) { const u32x2 zq = *(const LAS u32x2*)(zl + i * DA + 256 * j + 4 * lane); z[j] = (f32x4){bflo(zq.x), bfhi(zq.x), bflo(zq.y), bfhi(zq.y)}; s += (z[j][0] + z[j][1]) + (z[j][2] + z[j][3]); }
                const float mean = wave_sum(s) * (1.0f / DA); float q = 0.f;
#pragma unroll
                for (int j = 0; j < 4; ++j) { z[j] = z[j] - mean; q += (z[j][0] * z[j][0] + z[j][1] * z[j][1]) + (z[j][2] * z[j][2] + z[j][3] * z[j][3]); }
                const float rstd = rsq(wave_sum(q) * (1.0f / DA) + EPS);
                unsigned char* yrow = (unsigned char*)Hb + (size_t)t * D;
#pragma unroll
                for (int j = 0; j < 4; ++j) {
                    f32x4 v = z[j] * rstd * lng[j] + lnb[j]; float ss = 0.f;
#pragma unroll
                    for (int e = 0; e < 4; ++e) { v[e] = v[e] * fast_sigmoid(v[e]); ss += v[e] * v[e]; }
                    ss = row_sum16(ss);
                    const float r = rsq(ss * (1.0f / 64.0f) + EPS);
                    const f32x4 o = v * (r * SC_YM) * hnb[j];
                    *(unsigned*)(yrow + DA + 256 * j + 4 * lane) = pk4_fp8(o[0], o[1], o[2], o[3]);
                }
#pragma unroll
                for (int j = 0; j < 4; ++j) { const int c = 256 * j + 4 * lane;
                    const u32x2 u0 = pu0[j], u1 = pu1[j], u2 = pu2[j], bb = pbb[j];
                    f32x4 U0 = (f32x4){bflo(u0.x), bfhi(u0.x), bflo(u0.y), bfhi(u0.y)}, U1 = (f32x4){bflo(u1.x), bfhi(u1.x), bflo(u1.y), bfhi(u1.y)}, U2 = (f32x4){bflo(u2.x), bfhi(u2.x), bflo(u2.y), bfhi(u2.y)};
                    const f32x4 Bq = (f32x4){bflo(bb.x), bfhi(bb.x), bflo(bb.y), bfhi(bb.y)};
                    const f32x4 ya = Bq * (cw0[j] * U2 + cw1[j] * U1 + cw2[j] * U0);
                    float ss = (ya[0] * ya[0] + ya[1] * ya[1]) + (ya[2] * ya[2] + ya[3] * ya[3]);
                    ss = row_sum16(ss);
                    const float r = rsq(ss * (1.0f / 64.0f) + EPS);
                    const f32x4 o = ya * (r * SC_YM) * hna[j];
                    *(unsigned*)(yrow + c) = pk4_fp8(o[0], o[1], o[2], o[3]); }
            }
        }
        __syncthreads();
    }
#undef P3_LOAD_TILE
#undef P3_STORE_TILE
#undef P3_LOAD_W
#undef P3_CONV
    SEAM(3);

    if (IN(4)) {
        KArgsP ap = kargs(); unsigned char* ws = ap->ws;
        const float* x = ap->in[0];
        WSP(float, mod, WS_MOD); WSP(float, ssq, WS_SSQ); WSP(bf16_t, WoutT, WS_WOUTT); WSP(bf16_t, Hb, WS_H); WSP(bf16_t, X2, WS_X2);
        pg8::DenseOrderG S; S.init(T, D, D, G, bx, WoutT);
        pg8::EpiOut E{x, mod, X2, ssq};
        pg8::gemm_phase<true, pg8::EpiOut, pg8::DenseOrderG>(lds, Hb, (unsigned)T * D, WoutT, (unsigned)D * D, D, S, E);
    }
    SEAM(4);

    if (IN(5)) {
        KArgsP ap = kargs(); unsigned char* ws = ap->ws;
        const float* norm_ffn_g = ap->in[14]; const float* router_bias = ap->in[16]; WSP(bf16_t, X2, WS_X2);
        WSP(float, mod, WS_MOD); WSP(float, ssq, WS_SSQ); WSP(int, tok_e, WS_TOKE); WSP(int, tok_r, WS_TOKR); WSP(float, tok_w, WS_TOKW); WSP(int, inv_tok, WS_INVT);
        WSP(bf16_t, WrThi, WS_WRT); bf16_t* WrTlo = WrThi + (size_t)NE * D; WSP(unsigned char, H2, WS_H2);
        unsigned* gcount = (unsigned*)(ws + WS_CTL) + CW_GCOUNT;
        LAS float* gsc = (LAS float*)lds; LAS float* shv = gsc + D;
        LAS unsigned char* slab = lds + 16384;
        LAS float* Sc = (LAS float*)(lds + 16384);
        LAS float* Mk = Sc + 128 * 65;
        LAS float* rbias = (LAS float*)(lds + 16384 + 65536 + 4096);
        LAS int* lcnt = (LAS int*)(rbias + 64); LAS int* lbase = lcnt + 64;
        for (int ch = bx; ch < T / 128; ch += G) {
            const int b = ch >> 4; const float* mb = mod + (size_t)b * (6 * D);
            __syncthreads();
            for (int k = tid; k < D; k += NTHR) { gsc[k] = norm_ffn_g[k] * (1.0f + mb[4 * D + k]); shv[k] = mb[3 * D + k]; }
            if (tid < NE) { rbias[tid] = router_bias[tid]; lcnt[tid] = 0; }
            __syncthreads();
            {
                const int r = lane & 15, q = lane >> 4, t = ch * 128 + wave * 16 + r;
                float s = 0.f;
#pragma unroll
                for (int p = 0; p < 8; ++p) s += ssq[(size_t)(q * 8 + p) * T + t];
                s += __shfl_xor(s, 16); s += __shfl_xor(s, 32);
                const float rstd = rsq(s * (1.0f / D) + EPS);
                f32x4 acc[4];
#pragma unroll
                for (int n = 0; n < 4; ++n) acc[n] = (f32x4){0.f, 0.f, 0.f, 0.f};
                const bf16_t* xrow = X2 + (size_t)t * D + 8 * q;
                unsigned char* hrow = H2 + (size_t)t * D + 8 * q;
                u32x4 xq[4];
#pragma unroll
                for (int s = 0; s < 4; ++s) xq[s] = *(const u32x4*)(xrow + 32 * s);
                unsigned sdst[4]; const bf16_t* ssrc[4];
#pragma unroll
                for (int j = 0; j < 4; ++j) { const int p = tid + 512 * j, hl = p >> 10, e = (p >> 4) & 63, kc = p & 15; const int ob = (e & 15) * 64 + (kc & 3) * 16;
                    sdst[j] = (unsigned)(((hl * 4 + (kc >> 2)) * 4 + (e >> 4)) * 1024 + (ob ^ (((ob >> 9) & 1) << 5))); ssrc[j] = (hl ? WrTlo : WrThi) + (size_t)e * D + 8 * kc; }
                const int fo = r * 64 + q * 16, foff = fo ^ (((fo >> 9) & 1) << 5);
                u32x4 sreg[4];
#pragma unroll
                for (int j = 0; j < 4; ++j) sreg[j] = *(const u32x4*)(ssrc[j]);
#pragma unroll
                for (int j = 0; j < 4; ++j) *(LAS u32x4*)(slab + sdst[j]) = sreg[j];
                __syncthreads();
#pragma unroll 1
                for (int k0 = 0; k0 < D; k0 += 128) {
                    const int it = k0 >> 7; LAS unsigned char* sb = slab + (it & 1) * 32768;
                    const int kn = (k0 + 128 < D) ? k0 + 128 : k0;
#pragma unroll
                    for (int j = 0; j < 4; ++j) sreg[j] = *(const u32x4*)(ssrc[j] + kn);
#pragma unroll
                    for (int s = 0; s < 4; ++s) {
                        const int kk = k0 + 32 * s;
                        const f32x4 ga = *(const LAS f32x4*)(gsc + kk + 8 * q), gb = *(const LAS f32x4*)(gsc + kk + 8 * q + 4);
                        const f32x4 sa = *(const LAS f32x4*)(shv + kk + 8 * q), sb4 = *(const LAS f32x4*)(shv + kk + 8 * q + 4);
                        const f32x4 xa4 = (f32x4){bflo(xq[s].x), bfhi(xq[s].x), bflo(xq[s].y), bfhi(xq[s].y)}, xb4 = (f32x4){bflo(xq[s].z), bfhi(xq[s].z), bflo(xq[s].w), bfhi(xq[s].w)};
                        const f32x4 ha = xa4 * rstd * ga + sa, hb = xb4 * rstd * gb + sb4;
                        const int kx = (kk + 128 < D) ? kk + 128 : kk;
                        xq[s] = *(const u32x4*)(xrow + kx);
                        u32x4 ph, pl;
                        ph.x = pk2(ha[0], ha[1]); ph.y = pk2(ha[2], ha[3]); ph.z = pk2(hb[0], hb[1]); ph.w = pk2(hb[2], hb[3]);
                        pl.x = pk2(ha[0] - bflo(ph.x), ha[1] - bfhi(ph.x)); pl.y = pk2(ha[2] - bflo(ph.y), ha[3] - bfhi(ph.y));
                        pl.z = pk2(hb[0] - bflo(ph.z), hb[1] - bfhi(ph.z)); pl.w = pk2(hb[2] - bflo(ph.w), hb[3] - bfhi(ph.w));
                        { u32x2 h8; h8.x = pk4_fp8(ha[0] * SC_H2, ha[1] * SC_H2, ha[2] * SC_H2, ha[3] * SC_H2); h8.y = pk4_fp8(hb[0] * SC_H2, hb[1] * SC_H2, hb[2] * SC_H2, hb[3] * SC_H2); *(u32x2*)(hrow + kk) = h8; }
                        const bf16x8 Ah = __builtin_bit_cast(bf16x8, ph), Al = __builtin_bit_cast(bf16x8, pl);
#pragma unroll
                        for (int n = 0; n < 4; ++n) {
                            const bf16x8 Bh = *(const LAS bf16x8*)(sb + ((0 * 4 + s) * 4 + n) * 1024 + foff), Bl = *(const LAS bf16x8*)(sb + ((1 * 4 + s) * 4 + n) * 1024 + foff);
                            acc[n] = __builtin_amdgcn_mfma_f32_16x16x32_bf16(Bh, Ah, acc[n], 0, 0, 0);
                            acc[n] = __builtin_amdgcn_mfma_f32_16x16x32_bf16(Bl, Ah, acc[n], 0, 0, 0);
                            acc[n] = __builtin_amdgcn_mfma_f32_16x16x32_bf16(Bh, Al, acc[n], 0, 0, 0);
                        }
                    }
#pragma unroll
                    for (int j = 0; j < 4; ++j) *(LAS u32x4*)(slab + ((it + 1) & 1) * 32768 + sdst[j]) = sreg[j];
                    __syncthreads();
                }
#pragma unroll
                for (int n = 0; n < 4; ++n)
#pragma unroll
                    for (int i = 0; i < 4; ++i) Sc[(wave * 16 + r) * 65 + 16 * n + 4 * q + i] = 1.0f / (1.0f + expf(-acc[n][i]));
            }
            __syncthreads();
            int idx[TOPK]; float wk[TOPK]; int lr[TOPK];
            const int tl = tid;
            if (tid < 128) {
                LAS float* srow = Sc + tl * 65; LAS float* mrow = Mk + tl * 65;
                float gs[8];
#pragma unroll
                for (int g = 0; g < 8; ++g) { float m1 = -INFINITY, m2 = -INFINITY;
#pragma unroll
                    for (int j = 0; j < 8; ++j) { const float v = srow[8 * g + j] + rbias[8 * g + j]; mrow[8 * g + j] = v; if (v > m1) { m2 = m1; m1 = v; } else if (v > m2) m2 = v; }
                    gs[g] = m1 + m2; }
                unsigned sel = 0u;
#pragma unroll
                for (int g = 0; g < 8; ++g) { int rank = 0;
#pragma unroll
                    for (int h = 0; h < 8; ++h) rank += (gs[h] > gs[g] || (gs[h] == gs[g] && h < g)) ? 1 : 0;
                    if (rank < 4) sel |= 1u << g; }
#pragma unroll
                for (int g = 0; g < 8; ++g) if (!((sel >> g) & 1u)) {
#pragma unroll
                    for (int j = 0; j < 8; ++j) mrow[8 * g + j] = -INFINITY; }
                float wsum = 0.f;
#pragma unroll
                for (int k = 0; k < TOPK; ++k) { float best = -INFINITY; int bi = 0;
#pragma unroll 8
                    for (int e = 0; e < NE; ++e) { const float v = mrow[e]; if (v > best) { best = v; bi = e; } }
                    mrow[bi] = -INFINITY; idx[k] = bi; wk[k] = srow[bi]; wsum += wk[k]; }
                const float inv = 2.5f / wsum;
#pragma unroll
                for (int k = 0; k < TOPK; ++k) { wk[k] *= inv; lr[k] = atomicAdd((int*)&lcnt[idx[k]], 1); }
            }
            __syncthreads();
            if (tid < NE) lbase[tid] = (int)atomicAdd(&gcount[tid], (unsigned)lcnt[tid]);
            __syncthreads();
            if (tid < 128) { const int t = ch * 128 + tl;
#pragma unroll
                for (int k = 0; k < TOPK; ++k) { const int e = idx[k], rank = lbase[e] + lr[k];
                    tok_e[t * 8 + k] = e; tok_r[t * 8 + k] = rank; tok_w[t * 8 + k] = wk[k]; inv_tok[e * T + rank] = t; }
                inv_tok[NE * T + t] = t; }
        }
        __syncthreads();
    }
    SEAM(5);

    if (IN(6)) {
        KArgsP ap = kargs(); unsigned char* ws = ap->ws;
        WSP(int, inv_tok, WS_INVT); WSP(unsigned char, W1T, WS_W1T); WSP(unsigned char, H2, WS_H2); WSP(unsigned char, ACT, WS_ACT);
        unsigned* gcount = (unsigned*)(ws + WS_CTL) + CW_GCOUNT;
        int NBr; build_tables(lds, gcount, NBr);
        pg8::MoeOrder<0, 4> S; S.blk_e = lds + TBL_BLKE; S.blkstart = (const LAS int*)(lds + TBL_BSTART); S.cnt = (const LAS int*)(lds + TBL_CNT);
        S.NB = NBr + 128; S.G = G; S.vcu = vcu; S.KB = D; S.Bt = W1T; S.estride = 1024u * D; S.boff0 = 0; S.inv_tok = inv_tok;
        pg8::EpiAct E{ACT};
        pg8::gemm_phase<true, pg8::EpiAct, pg8::MoeOrder<0, 4>>(lds, H2, (unsigned)T * D, W1T, 65u * 1024u * D, D, S, E);
    }
    SEAM(6);

    if (IN(7)) {
        KArgsP ap = kargs(); unsigned char* ws = ap->ws;
        WSP(int, inv_tok, WS_INVT); WSP(unsigned char, W2T, WS_W2T); WSP(unsigned char, ACT, WS_ACT); WSP(unsigned char, YR, WS_Y);
        unsigned* gcount = (unsigned*)(ws + WS_CTL) + CW_GCOUNT;
        int NBr; build_tables(lds, gcount, NBr);
        pg8::MoeOrder<1, 8> S; S.blk_e = lds + TBL_BLKE; S.blkstart = (const LAS int*)(lds + TBL_BSTART); S.cnt = (const LAS int*)(lds + TBL_CNT);
        S.NB = NBr + 128; S.G = G; S.vcu = vcu; S.KB = FE; S.Bt = W2T; S.estride = (unsigned)D * FE; S.boff0 = 0; S.inv_tok = inv_tok;
        pg8::EpiY8 E{YR};
        pg8::gemm_phase<true, pg8::EpiY8, pg8::MoeOrder<1, 8>>(lds, ACT, (unsigned)MAXBLK * 256 * FE, W2T, 65u * D * FE, FE, S, E);
    }
    SEAM(7);

    if (IN(8)) {
        KArgsP ap = kargs(); unsigned char* ws = ap->ws;
        const float* norm_final_g = ap->in[23]; float* out = ap->out;
        WSP(float, mod, WS_MOD); WSP(int, tok_e, WS_TOKE); WSP(int, tok_r, WS_TOKR); WSP(float, tok_w, WS_TOKW); WSP(unsigned char, YR, WS_Y); WSP(bf16_t, X2, WS_X2);
        unsigned* gcount = (unsigned*)(ws + WS_CTL) + CW_GCOUNT;
        int NBr; build_tables(lds, gcount, NBr);
        const LAS int* blkstart = (const LAS int*)(lds + TBL_BSTART);
        const int tstride = G * NWAVES;
        for (int t0 = vcu * NWAVES + wave; t0 < T; t0 += 2 * tstride) {
            int tt[2]; tt[0] = t0; tt[1] = (t0 + tstride < T) ? t0 + tstride : t0;
            f32x4 a[2][8];
#pragma unroll
            for (int u = 0; u < 2; ++u)
#pragma unroll
                for (int j = 0; j < 8; ++j) a[u][j] = (f32x4){0.f, 0.f, 0.f, 0.f};
#pragma unroll 3
            for (int k = 0; k < TOPK + 1; ++k) {
#pragma unroll
                for (int u = 0; u < 2; ++u) { const int t = tt[u];
                    int row; float w; constexpr float ys = 1.0f / SC_Y;
                    if (k < TOPK) { const int e = tok_e[t * 8 + k]; row = 256 * blkstart[e] + tok_r[t * 8 + k]; w = tok_w[t * 8 + k] * ys; } else { row = 256 * NBr + t; w = ys; }
                    const unsigned char* yr = YR + (size_t)row * D + 4 * lane;
#pragma unroll
                    for (int j = 0; j < 8; ++j) { const unsigned y1 = *(const unsigned*)(yr + 256 * j);
                        const f32x2 p0 = __builtin_amdgcn_cvt_pk_f32_fp8((int)y1, false), p1 = __builtin_amdgcn_cvt_pk_f32_fp8((int)y1, true);
                        a[u][j] = a[u][j] + w * (f32x4){p0.x, p0.y, p1.x, p1.y}; } }
            }
#pragma unroll
            for (int u = 0; u < 2; ++u) { const int t = tt[u]; const int b = t >> 11; const float* gf = mod + (size_t)b * (6 * D) + 5 * D;
                float* orow = out + (size_t)t * D; const bf16_t* xrow = X2 + (size_t)t * D;
                float ss = 0.f;
#pragma unroll
                for (int j = 0; j < 8; ++j) { const int c = 256 * j + 4 * lane; const u32x2 xq = *(const u32x2*)(xrow + c);
                    const f32x4 xv = (f32x4){bflo(xq.x), bfhi(xq.x), bflo(xq.y), bfhi(xq.y)}, g4 = *(const f32x4*)(gf + c);
                    a[u][j] = xv + g4 * a[u][j]; ss += (a[u][j][0] * a[u][j][0] + a[u][j][1] * a[u][j][1]) + (a[u][j][2] * a[u][j][2] + a[u][j][3] * a[u][j][3]); }
                const float rstd = rsq(wave_sum(ss) * (1.0f / D) + EPS);
#pragma unroll
                for (int j = 0; j < 8; ++j) { const int c = 256 * j + 4 * lane; const f32x4 g0 = *(const f32x4*)(norm_final_g + c); *(f32x4*)(orow + c) = a[u][j] * rstd * g0; }
            }
        }
    }
#undef IN
#undef SEAM
}

extern "C" void kernel_launch(void* const* d_in, const int* in_sizes, int n_in, void* d_out, int out_size, void* d_ws, size_t ws_size, hipStream_t stream) {
    static int grid = 0;
    if (grid == 0) {
        if (n_in != 24 || out_size != T * D || ws_size < WS_END) { fprintf(stderr, "kernel_launch: unexpected problem (n_in %d, out %d, ws %zu)\n", n_in, out_size, ws_size); grid = -1; return; }
        int dev = 0, cus = 0, per_cu = 0;
        if (hipGetDevice(&dev) != hipSuccess || hipDeviceGetAttribute(&cus, hipDeviceAttributeMultiprocessorCount, dev) != hipSuccess) { grid = -1; return; }
        if (hipFuncSetAttribute((const void*)fwd_kernel, hipFuncAttributeMaxDynamicSharedMemorySize, LDS_BYTES) != hipSuccess) { fprintf(stderr, "kernel_launch: hipFuncSetAttribute failed\n"); grid = -1; return; }
        if (hipOccupancyMaxActiveBlocksPerMultiprocessor(&per_cu, (const void*)fwd_kernel, NTHR, LDS_BYTES) != hipSuccess || per_cu < 1) { fprintf(stderr, "kernel_launch: occupancy query says %d\n", per_cu); }
        (void)hipGetLastError();
        grid = cus;
    }
    if (grid < 0) return;
    (void)hipMemsetAsync((char*)d_ws + WS_CTL, 0, CTL_ZERO_BYTES, stream);
    Args a{};
    for (int i = 0; i < 24; ++i) a.in[i] = (const float*)d_in[i];
    a.out = (float*)d_out; a.ws = (unsigned char*)d_ws;
    constexpr int NPH = 9;
    if (MK_N_LAUNCHES == 1) {
        a.ph_lo = 0; a.ph_hi = NPH;
        hipLaunchKernelGGL(fwd_kernel, dim3(grid), dim3(NTHR), LDS_BYTES, stream, a);
    } else {
        for (int p = 0; p < NPH; ++p) { const int reps = ((REPEAT_MASK >> p) & 1) ? 2 : 1;
            for (int r = 0; r < reps; ++r) { if (p == 5 && r > 0) (void)hipMemsetAsync((char*)d_ws + WS_CTL + CW_GCOUNT * 4, 0, 256, stream);
                a.ph_lo = p; a.ph_hi = p + 1; hipLaunchKernelGGL(fwd_kernel, dim3(grid), dim3(NTHR), LDS_BYTES, stream, a); } }
    }
}
```
